# Optimizing an MI355X kernel written in HIP

```python
import math
import jax, jax.numpy as jnp
from jax import lax
import numpy as np

D_MODEL = 1024
BATCH = 8
SEQ = 4096
DEPTH = 1

CHUNK = 64
Q_BLOCK = 128
ROPE_THETA = 10000.0
EPS = 1e-6
DA_HEADS = 8
DA_V_DIM = D_MODEL // DA_HEADS
DA_QK_DIM = DA_V_DIM // 2
DA_WIDTH = DA_HEADS * DA_V_DIM
RET_HEADS = 4
RET_V_DIM = D_MODEL // RET_HEADS
RET_K_DIM = RET_V_DIM // 2
RET_WIDTH = RET_HEADS * RET_V_DIM
D_FF = 4 * D_MODEL
N_BRANCH = 2
N_MOD = 6
COL_SIZES = (
    DA_HEADS * 2 * DA_QK_DIM,
    DA_HEADS * 2 * DA_QK_DIM,
    DA_WIDTH,
    RET_HEADS * RET_K_DIM,
    RET_HEADS * RET_K_DIM,
    RET_WIDTH,
    RET_WIDTH,
    N_BRANCH * D_MODEL,
)
COL_SPLITS = tuple(int(s) for s in np.cumsum(COL_SIZES)[:-1])
IN_COLS = int(sum(COL_SIZES))

kernel_name = "hybrid_diffattn_retention_block"


def rms_norm(x, g):
    x32 = x.astype(jnp.float32)
    y = x32 * lax.rsqrt(jnp.mean(x32 * x32, axis=-1, keepdims=True) + EPS)
    return (y * g.astype(jnp.float32)).astype(x.dtype)


def rope(x, inv_freq):
    s = x.shape[-2]
    ang = jnp.arange(s, dtype=jnp.float32)[:, None] * inv_freq[None, :]
    cos = jnp.cos(ang).astype(x.dtype)
    sin = jnp.sin(ang).astype(x.dtype)
    x1, x2 = jnp.split(x, 2, axis=-1)
    return jnp.concatenate([x1 * cos - x2 * sin, x2 * cos + x1 * sin], axis=-1)


def diff_attention(q, k, v, lam):
    b, h, _, s, d = q.shape
    nb = s // Q_BLOCK
    qb = q.reshape(b, h, 2, nb, Q_BLOCK, d).transpose(3, 0, 1, 2, 4, 5)
    key_chunk = jnp.arange(s) // CHUNK

    def block(args):
        qi, bi = args
        sc = jnp.einsum('bhmqd,bhmkd->bhmqk', qi, k).astype(jnp.float32)
        q_chunk = (bi * Q_BLOCK + jnp.arange(Q_BLOCK)) // CHUNK
        mask = key_chunk[None, :] <= q_chunk[:, None]
        p = jax.nn.softmax(jnp.where(mask, sc, -jnp.inf), axis=-1)
        a = p[:, :, 0] - lam * p[:, :, 1]
        return jnp.einsum('bhqk,bhkd->bhqd', a.astype(v.dtype), v)

    out = lax.map(block, (qb, jnp.arange(nb)))
    return out.transpose(1, 2, 0, 3, 4).reshape(b, h, s, v.shape[-1])


def retention(q, k, v, log_gamma):
    b, h, s, dk = q.shape
    dv = v.shape[-1]
    nc = s // CHUNK
    f32 = jnp.float32

    def to_chunks(t):
        return t.astype(f32).reshape(b, h, nc, CHUNK, t.shape[-1]).transpose(2, 0, 1, 3, 4)

    n = jnp.arange(CHUNK, dtype=f32)
    lg = log_gamma[:, None, None]
    diff = n[:, None] - n[None, :]
    d_intra = jnp.where(diff >= 0, jnp.exp(jnp.maximum(diff, 0.0) * lg), 0.0)
    inner_decay = jnp.exp((n + 1.0)[None, :] * log_gamma[:, None])[..., None]
    kv_decay = jnp.exp((CHUNK - 1.0 - n)[None, :] * log_gamma[:, None])[..., None]
    chunk_decay = jnp.exp(CHUNK * log_gamma)[:, None, None]

    def step(state, inp):
        qc, kc, vc = inp
        sc = jnp.einsum('bhid,bhjd->bhij', qc, kc) * d_intra
        y = (jnp.einsum('bhij,bhjv->bhiv', sc, vc)
             + jnp.einsum('bhid,bhdv->bhiv', qc, state) * inner_decay)
        state = state * chunk_decay + jnp.einsum('bhjd,bhjv->bhdv', kc * kv_decay, vc)
        return state, y

    state0 = jnp.zeros((b, h, dk, dv), f32)
    _, ys = lax.scan(step, state0, (to_chunks(q), to_chunks(k), to_chunks(v)))
    return ys.transpose(1, 2, 0, 3, 4).reshape(b, h, s, dv).astype(v.dtype)


def setup_inputs(seed: int = 0) -> dict:
    key = jax.random.key(seed)
    ks = jax.random.split(key, 20)
    f32 = jnp.float32
    nrm = lambda k, shp, sc: (jax.random.normal(k, shp, f32) * sc).astype(f32)
    gain = lambda k, shp: 1.0 + 0.02 * jax.random.normal(k, shp, f32)
    return {
        "x": nrm(ks[0], (BATCH, SEQ, D_MODEL), 1.0),
        "c": nrm(ks[1], (BATCH, D_MODEL), 1.0),
        "w_ada": nrm(ks[2], (DEPTH, D_MODEL, N_MOD * D_MODEL), 0.2 * D_MODEL ** -0.5),
        "b_ada": nrm(ks[3], (DEPTH, N_MOD * D_MODEL), 0.01),
        "g_norm1": gain(ks[4], (DEPTH, D_MODEL)),
        "w_in": nrm(ks[5], (DEPTH, D_MODEL, IN_COLS), D_MODEL ** -0.5),
        "g_q": gain(ks[6], (DEPTH, DA_QK_DIM)),
        "g_k": gain(ks[7], (DEPTH, DA_QK_DIM)),
        "lambda_q1": nrm(ks[8], (DEPTH, DA_QK_DIM), 0.1),
        "lambda_k1": nrm(ks[9], (DEPTH, DA_QK_DIM), 0.1),
        "lambda_q2": nrm(ks[10], (DEPTH, DA_QK_DIM), 0.1),
        "lambda_k2": nrm(ks[11], (DEPTH, DA_QK_DIM), 0.1),
        "g_da_out": gain(ks[12], (DEPTH, DA_V_DIM)),
        "g_ret_out": gain(ks[13], (DEPTH, RET_V_DIM)),
        "w_out": nrm(ks[14], (DEPTH, D_MODEL, D_MODEL), D_MODEL ** -0.5),
        "g_norm2": gain(ks[15], (DEPTH, D_MODEL)),
        "w_up": nrm(ks[16], (DEPTH, D_MODEL, D_FF), D_MODEL ** -0.5),
        "w_down": nrm(ks[17], (DEPTH, D_FF, D_MODEL), D_FF ** -0.5),
    }


def reference(x, c, w_ada, b_ada, g_norm1, w_in, g_q, g_k, lambda_q1, lambda_k1,
              lambda_q2, lambda_k2, g_da_out, g_ret_out, w_out, g_norm2, w_up, w_down):
    b, s, d = x.shape
    f32 = jnp.float32
    da_inv_freq = ROPE_THETA ** (-jnp.arange(0, DA_QK_DIM, 2, dtype=f32) / DA_QK_DIM)
    ret_inv_freq = 1.0 / (ROPE_THETA ** jnp.linspace(0.0, 1.0, RET_K_DIM // 2, dtype=f32))
    log_gamma = jnp.asarray(np.log(1.0 - 2.0 ** (-5.0 - np.arange(RET_HEADS))).astype(np.float32))

    for l in range(DEPTH):
        lambda_init = 0.8 - 0.6 * math.exp(-0.3 * l)
        mod = jax.nn.silu(c) @ w_ada[l] + b_ada[l]
        shift1, scale1, gate1, shift2, scale2, gate2 = [m[:, None, :] for m in jnp.split(mod, N_MOD, axis=-1)]

        hmix = rms_norm(x, g_norm1[l]) * (1.0 + scale1) + shift1
        proj = hmix @ w_in[l]
        qa, ka, va, qr, kr, vr, gr_swish, merge = jnp.split(proj, COL_SPLITS, axis=-1)

        qa = qa.reshape(b, s, DA_HEADS, 2, DA_QK_DIM).transpose(0, 2, 3, 1, 4)
        ka = ka.reshape(b, s, DA_HEADS, 2, DA_QK_DIM).transpose(0, 2, 3, 1, 4)
        va = va.reshape(b, s, DA_HEADS, DA_V_DIM).transpose(0, 2, 1, 3)
        qa = rope(rms_norm(qa, g_q[l]), da_inv_freq) * (DA_QK_DIM ** -0.5)
        ka = rope(rms_norm(ka, g_k[l]), da_inv_freq)
        lam = (jnp.exp(jnp.sum(lambda_q1[l].astype(f32) * lambda_k1[l].astype(f32)))
               - jnp.exp(jnp.sum(lambda_q2[l].astype(f32) * lambda_k2[l].astype(f32)))
               + lambda_init)
        oa = diff_attention(qa, ka, va, lam)
        oa = rms_norm(oa, g_da_out[l]) * (1.0 - lambda_init)
        oa = oa.transpose(0, 2, 1, 3).reshape(b, s, DA_WIDTH)

        qr = qr.reshape(b, s, RET_HEADS, RET_K_DIM).transpose(0, 2, 1, 3)
        kr = kr.reshape(b, s, RET_HEADS, RET_K_DIM).transpose(0, 2, 1, 3)
        vr = vr.reshape(b, s, RET_HEADS, RET_V_DIM).transpose(0, 2, 1, 3)
        qr = rope(qr, ret_inv_freq)
        kr = rope(kr, ret_inv_freq) * (RET_K_DIM ** -0.5)
        orr = rms_norm(retention(qr, kr, vr, log_gamma), g_ret_out[l])
        orr = orr.transpose(0, 2, 1, 3).reshape(b, s, RET_WIDTH) * jax.nn.silu(gr_swish)

        ga, gb = jnp.split(jax.nn.sigmoid(merge), N_BRANCH, axis=-1)
        y = (ga * oa + gb * orr) @ w_out[l]
        x = x + gate1 * y

        hff = rms_norm(x, g_norm2[l]) * (1.0 + scale2) + shift2
        ff = jnp.square(jax.nn.relu(hff @ w_up[l])) @ w_down[l]
        x = x + gate2 * ff
    return x
```

```cpp
#include <hip/hip_runtime.h>
#include <hip/hip_cooperative_groups.h>
#include <cstdio>
namespace cg = cooperative_groups;

typedef unsigned short bf16_t;
constexpr int D = 1024, NBATCH = 8, S = 4096, MTOK = NBATCH * S, DFF = 4096, INC = 8192;
constexpr int NB = 4;
constexpr int NG = NBATCH / NB;
constexpr int MG = NB * S;
constexpr float EPS = 1e-6f;
constexpr int NTHR = 512;
constexpr size_t LDS_BYTES = 144 * 1024;

struct P {
  const float *x, *c, *w_ada, *b_ada, *g1, *w_in, *gq, *gk, *lq1, *lk1, *lq2, *lk2, *gda, *gret, *w_out, *g2, *w_up, *w_down;
  float* out;
  char* ws;
};

constexpr size_t al(size_t x) { return (x + 255) & ~(size_t)255; }
constexpr size_t OFF_MOD = 0;
constexpr size_t OFF_TABA = al(OFF_MOD + 8 * 6144 * 4);
constexpr size_t OFF_TABR = al(OFF_TABA + 4096 * 32 * 8);
constexpr size_t OFF_CNT = al(OFF_TABR + 4096 * 64 * 8);
constexpr size_t OFF_BAR = al(OFF_CNT + 256);
constexpr size_t OFF_WIN = al(OFF_BAR + 3456 * 4);
constexpr size_t OFF_WOUT = al(OFF_WIN + (size_t)8192 * 1024 * 2);
constexpr size_t OFF_WUP = al(OFF_WOUT + (size_t)1024 * 2048 * 2);
constexpr size_t OFF_WDN = al(OFF_WUP + (size_t)4096 * 1024 * 2);
constexpr size_t OFF_GRP = al(OFF_WDN + (size_t)1024 * 4096 * 2);
constexpr size_t OFF_HMIX = OFF_GRP;
constexpr size_t OFF_QA = al(OFF_HMIX + (size_t)MG * 1024 * 2);
constexpr size_t OFF_KA = al(OFF_QA + (size_t)MG * 1024 * 2);
constexpr size_t OFF_VAT = al(OFF_KA + (size_t)MG * 1024 * 2);
constexpr size_t OFF_QR = al(OFF_VAT + (size_t)MG * 1024 * 2);
constexpr size_t OFF_KR = al(OFF_QR + (size_t)MG * 512 * 2);
constexpr size_t OFF_VRT = al(OFF_KR + (size_t)MG * 512 * 2);
constexpr size_t OFF_SG = al(OFF_VRT + (size_t)MG * 1024 * 2);
constexpr size_t OFF_MGT = al(OFF_SG + (size_t)MG * 1024 * 2);
constexpr size_t OFF_U = al(OFF_MGT + (size_t)MG * 2048 * 2);
constexpr size_t OFF_KRT = al(OFF_U + (size_t)MG * 2048 * 2);
constexpr size_t OFF_SNAP = al(OFF_KRT + (size_t)MG * 512 * 2);
constexpr size_t OFF_GRP_END = al(OFF_SNAP + (size_t)NB * 4 * 64 * 65536);
static_assert(OFF_GRP_END <= (size_t)512 * 1024 * 1024, "ws overflow");
constexpr size_t OFF_HFF = OFF_GRP;
constexpr size_t OFF_HID = al(OFF_HFF + (size_t)MTOK * 1024 * 2);
constexpr size_t OFF_FFN_END = al(OFF_HID + (size_t)MTOK * 4096 * 2);
static_assert(OFF_FFN_END <= (size_t)512 * 1024 * 1024, "ws overflow");

__device__ __forceinline__ bf16_t f2bf(float f) {
  unsigned u = __float_as_uint(f);
  u += 0x7fffu + ((u >> 16) & 1u);
  return (bf16_t)(u >> 16);
}
__device__ __forceinline__ unsigned cvtpk(float lo, float hi) {
  unsigned r;
  asm volatile("v_cvt_pk_bf16_f32 %0, %1, %2" : "=v"(r) : "v"(lo), "v"(hi));
  return r;
}
__device__ __forceinline__ int opaque_tid(const int wv) {
  int l;
  asm volatile("v_mbcnt_lo_u32_b32 %0, -1, 0\n\tv_mbcnt_hi_u32_b32 %0, -1, %0" : "=v"(l));
  return wv * 64 + l;
}
__device__ __forceinline__ float bf2f(bf16_t h) { return __uint_as_float(((unsigned)h) << 16); }
__device__ __forceinline__ float sigmoidf_(float v) { return 1.f / (1.f + __expf(-v)); }

__device__ __forceinline__ float block_sum(float v, float* red, int tid) {
  for (int o = 32; o > 0; o >>= 1) v += __shfl_xor(v, o);
  __syncthreads();
  if ((tid & 63) == 0) red[tid >> 6] = v;
  __syncthreads();
  float s = 0.f;
  for (int i = 0; i < (int)(blockDim.x >> 6); ++i) s += red[i];
  return s;
}

__device__ void phase_mod(const P& p, float* sm, const int wv) {
  float* mod = (float*)(p.ws + OFF_MOD);
  float2* tabA = (float2*)(p.ws + OFF_TABA);
  float2* tabR = (float2*)(p.ws + OFF_TABR);
  const int tid = opaque_tid(wv);
  int gt = blockIdx.x * blockDim.x + tid, gs = gridDim.x * blockDim.x;
  {
    float* sc = sm;
    float* red = sm + 8192;
    for (int slab = blockIdx.x; slab < 192; slab += gridDim.x) {
      __syncthreads();
      for (int i = tid; i < 8192; i += NTHR) { float cv = p.c[i]; sc[i] = cv / (1.f + __expf(-cv)); }
      __syncthreads();
      const int col = slab * 32 + (tid & 31), kp = tid >> 5;
      float acc[8];
#pragma unroll
      for (int bb = 0; bb < 8; ++bb) acc[bb] = 0.f;
      const float* wp = p.w_ada + (size_t)(kp * 64) * 6144 + col;
#pragma unroll 8
      for (int k = 0; k < 64; ++k) {
        const float w = wp[(size_t)k * 6144];
#pragma unroll
        for (int bb = 0; bb < 8; ++bb) acc[bb] += sc[bb * 1024 + kp * 64 + k] * w;
      }
#pragma unroll
      for (int bb = 0; bb < 8; ++bb) red[(kp * 8 + bb) * 32 + (tid & 31)] = acc[bb];
      __syncthreads();
      if (tid < 256) {
        const int bb = tid >> 5, cc = tid & 31;
        float s = p.b_ada[slab * 32 + cc];
#pragma unroll
        for (int q = 0; q < 16; ++q) s += red[(q * 8 + bb) * 32 + cc];
        mod[bb * 6144 + slab * 32 + cc] = s;
      }
    }
  }
  for (int o = gt; o < 4096 * 32; o += gs) {
    int s = o / 32, i = o % 32;
    float inv = powf(10000.f, -(float)(2 * i) / 64.f);
    float ang = (float)s * inv;
    tabA[o] = make_float2(cosf(ang), sinf(ang));
  }
  for (int o = gt; o < 4096 * 64; o += gs) {
    int s = o / 64, i = o % 64;
    float inv = 1.0f / powf(10000.f, (float)i / 63.f);
    float ang = (float)s * inv;
    tabR[o] = make_float2(cosf(ang), sinf(ang));
  }
}

__device__ void phase_norm(const float* src, const float* gain, const float* mod, int so, int sc, bf16_t* dst,
                           int tok0, int ntok, const int wv) {
  const int tid = opaque_tid(wv), lane = tid & 63, wid = tid >> 6;
  const int nwav = gridDim.x * 8, rpw = (ntok / nwav) & ~3;
  const int r0 = (blockIdx.x * 8 + wid) * rpw;
  const int b = (tok0 + r0) / S;
  const float* mb = mod + b * 6144 + lane * 4;
  const float* gp = gain + lane * 4;
  float4 mul[4], add[4];
#pragma unroll
  for (int i = 0; i < 4; ++i) {
    const float4 g = *(const float4*)(gp + i * 256);
    const float4 scl = *(const float4*)(mb + sc + i * 256);
    add[i] = *(const float4*)(mb + so + i * 256);
    mul[i] = make_float4(g.x * (1.f + scl.x), g.y * (1.f + scl.y), g.z * (1.f + scl.z), g.w * (1.f + scl.w));
  }
#pragma unroll 1
  for (int rb = 0; rb < rpw; rb += 4) {
    float4 v[4][4];
#pragma unroll
    for (int q = 0; q < 4; ++q) {
      const float* sp = src + (size_t)(tok0 + r0 + rb + q) * D + lane * 4;
#pragma unroll
      for (int i = 0; i < 4; ++i) v[q][i] = *(const float4*)(sp + i * 256);
    }
#pragma unroll
    for (int q = 0; q < 4; ++q) {
      float ss = 0.f;
#pragma unroll
      for (int i = 0; i < 4; ++i) ss += v[q][i].x * v[q][i].x + v[q][i].y * v[q][i].y + v[q][i].z * v[q][i].z + v[q][i].w * v[q][i].w;
#pragma unroll
      for (int o = 32; o > 0; o >>= 1) ss += __shfl_xor(ss, o);
      const float rstd = rsqrtf(ss * (1.f / D) + EPS);
      bf16_t* dp = dst + (size_t)(r0 + rb + q) * D + lane * 4;
#pragma unroll
      for (int i = 0; i < 4; ++i) {
        uint2 pk;
        pk.x = cvtpk(v[q][i].x * rstd * mul[i].x + add[i].x, v[q][i].y * rstd * mul[i].y + add[i].y);
        pk.y = cvtpk(v[q][i].z * rstd * mul[i].z + add[i].z, v[q][i].w * rstd * mul[i].w + add[i].w);
        *(uint2*)(dp + i * 256) = pk;
      }
    }
  }
  for (int r = nwav * rpw + blockIdx.x * 8 + wid; r < ntok; r += nwav) {
    const int T = tok0 + r, bb = T / S;
    const float* sp = src + (size_t)T * D + lane * 4;
    const float* mb2 = mod + bb * 6144 + lane * 4;
    float4 v[4];
#pragma unroll
    for (int i = 0; i < 4; ++i) v[i] = *(const float4*)(sp + i * 256);
    float ss = 0.f;
#pragma unroll
    for (int i = 0; i < 4; ++i) ss += v[i].x * v[i].x + v[i].y * v[i].y + v[i].z * v[i].z + v[i].w * v[i].w;
#pragma unroll
    for (int o = 32; o > 0; o >>= 1) ss += __shfl_xor(ss, o);
    const float rstd = rsqrtf(ss * (1.f / D) + EPS);
    bf16_t* dp = dst + (size_t)r * D + lane * 4;
#pragma unroll
    for (int i = 0; i < 4; ++i) {
      const float4 g = *(const float4*)(gp + i * 256);
      const float4 scl = *(const float4*)(mb2 + sc + i * 256);
      const float4 sh = *(const float4*)(mb2 + so + i * 256);
      uint2 pk;
      pk.x = cvtpk(v[i].x * rstd * g.x * (1.f + scl.x) + sh.x, v[i].y * rstd * g.y * (1.f + scl.y) + sh.y);
      pk.y = cvtpk(v[i].z * rstd * g.z * (1.f + scl.z) + sh.z, v[i].w * rstd * g.w * (1.f + scl.w) + sh.w);
      *(uint2*)(dp + i * 256) = pk;
    }
  }
}

#define LAS __attribute__((address_space(3)))
typedef short bf16x8 __attribute__((ext_vector_type(8)));
typedef float f32x4 __attribute__((ext_vector_type(4)));


__device__ __forceinline__ int perm32_slot(int f) { const int g = f & ~31, x = f & 31; return g + 16 * ((x >> 2) & 1) + 4 * (x >> 3) + (x & 3); }
__device__ __forceinline__ int win_row(int n) {
  const int tile = n >> 8, f = n & 255;
  if (n < 2048) { const int wc = f >> 6, q = f & 63; return (tile << 8) + 128 * (q >> 5) + 32 * wc + (q & 31); }
  if (n >= 3072 && n < 4096) { const int head = f >> 7, d = f & 127; return (tile << 8) + 128 * (d >> 6) + 32 * (head * 2 + ((d >> 5) & 1)) + (d & 31); }
  if (n >= 5120) return perm32_slot(n);
  return n;
}
__device__ void transpose_w(const float* W, int K, int N, bf16_t* dst, int ldd, int koff, float* sm, int wperm, const int wv) {
  const int tid = opaque_tid(wv);
  const int nkt = K / 64, nnt = N / 64, ntl = nkt * nnt;
  for (int t = blockIdx.x; t < ntl; t += 2 * gridDim.x) {
    __syncthreads();
#pragma unroll
    for (int u = 0; u < 2; ++u) {
      const int tu = t + u * gridDim.x;
      if (tu < ntl) {
        const int k0 = (tu / nnt) * 64, n0 = (tu % nnt) * 64;
#pragma unroll
        for (int r = 0; r < 8; ++r) {
          const int k = r * 8 + (tid >> 6), n = tid & 63;
          sm[u * 4160 + k * 65 + n] = W[(size_t)(k0 + k) * N + n0 + n];
        }
      }
    }
    __syncthreads();
#pragma unroll
    for (int u = 0; u < 2; ++u) {
      const int tu = t + u * gridDim.x;
      if (tu < ntl) {
        const int k0 = (tu / nnt) * 64, n0 = (tu % nnt) * 64;
        const int n = tid >> 3, ks = (tid & 7) * 8;
        const int nr = (wperm == 1) ? win_row(n0 + n) : (wperm == 2) ? perm32_slot(n0 + n) : (n0 + n);
        const float* s = sm + u * 4160 + n;
        uint4 pk;
        pk.x = cvtpk(s[(ks + 0) * 65], s[(ks + 1) * 65]); pk.y = cvtpk(s[(ks + 2) * 65], s[(ks + 3) * 65]);
        pk.z = cvtpk(s[(ks + 4) * 65], s[(ks + 5) * 65]); pk.w = cvtpk(s[(ks + 6) * 65], s[(ks + 7) * 65]);
        *(uint4*)(dst + (size_t)nr * ldd + koff + k0 + ks) = pk;
      }
    }
  }
}

__device__ __forceinline__ void tile_map(int t, int nM, int nN, int& pm, int& pn) {
  int w = t >> 8, l = t & 255, xcd = l & 7, idx = l >> 3;
  if ((nN & 15) == 0 && (nM & 15) == 0) {
    int sc = nN >> 4;
    int sr = w / sc, scc = w % sc;
    pm = sr * 16 + (xcd >> 1) * 4 + (idx >> 3);
    pn = scc * 16 + (xcd & 1) * 8 + (idx & 7);
  } else if (nN == 4 && (nM & 63) == 0) {
    pm = w * 64 + xcd * 8 + (idx >> 2);
    pn = idx & 3;
  } else {
    pm = t / nN; pn = t % nN;
  }
}


__device__ __forceinline__ int g8_lds_byte(int r, int c) {
  const int st = (r >> 4) * 2 + (c >> 5), rr = r & 15, cc = c & 31, ob = rr * 64 + cc * 2;
  return st * 1024 + (ob ^ (((ob >> 9) & 1) << 5));
}
__device__ __forceinline__ void g8_stage_rc(int b, int& R, int& C) {
  const int st = b / 1024, sb = b % 1024, swz = sb ^ (((sb >> 9) & 1) << 5);
  R = (st >> 1) * 16 + swz / 64; C = (st & 1) * 32 + (swz % 64) / 2;
}

template <class Epi>
__device__ __forceinline__ void gemm_phase(LAS char* lds, const char* Abase, const char* Bbase, const int K, const int nM, const int nN, const Epi& E, const int wv) {
  constexpr int HTB = 16384;
  const int tid = opaque_tid(wv), wid = __builtin_amdgcn_readfirstlane(tid >> 6), lane = tid & 63, wr = wid >> 2, wc = wid & 3, fr = lane & 15, fq = lane >> 4;
  const int nt = K / 64, ntiles = nM * nN;
  unsigned voff[2];
#pragma unroll
  for (int i = 0; i < 2; ++i) { int R, C; g8_stage_rc(tid * 16 + i * 8192, R, C); voff[i] = (unsigned)(R * K + C) * 2u; }
  const size_t kstep = 128, hstep = (size_t)128 * K * 2, tstep = 2 * hstep;
  const unsigned ldsw = (unsigned)wid * 1024u;
  const int aoff = g8_lds_byte(wr * 64 + fr, fq * 8), boff = g8_lds_byte(wc * 32 + fr, fq * 8);
#define G8_SA(b, h) (((b) * 2 + (h)) * HTB)
#define G8_SB(b, h) ((4 + (b) * 2 + (h)) * HTB)
#define G8_STAGE(bufoff, gbase) do { _Pragma("unroll") for (int _i = 0; _i < 2; ++_i) \
    __builtin_amdgcn_global_load_lds((const unsigned*)((const char*)(gbase) + voff[_i]), (LAS unsigned*)(lds + (bufoff) + ldsw + _i * 8192), 16, 0, 0); } while (0)
#define G8_LDA(dst, b, h) do { _Pragma("unroll") for (int m = 0; m < 4; ++m) _Pragma("unroll") for (int k = 0; k < 2; ++k) dst[m][k] = *(const LAS bf16x8*)(lds + G8_SA(b, h) + aoff + m * 2048 + k * 1024); } while (0)
#define G8_LDB(dst, b, h) do { _Pragma("unroll") for (int n = 0; n < 2; ++n) _Pragma("unroll") for (int k = 0; k < 2; ++k) dst[n][k] = *(const LAS bf16x8*)(lds + G8_SB(b, h) + boff + n * 2048 + k * 1024); } while (0)
#define G8_MMA(ai, bj, At, Bt) do { __builtin_amdgcn_s_setprio(1); _Pragma("unroll") for (int m = 0; m < 4; ++m) _Pragma("unroll") for (int n = 0; n < 2; ++n) _Pragma("unroll") for (int k = 0; k < 2; ++k) \
    acc[ai][bj][m][n] = __builtin_amdgcn_mfma_f32_16x16x32_bf16(Bt[n][k], At[m][k], acc[ai][bj][m][n], 0, 0, 0); __builtin_amdgcn_s_setprio(0); } while (0)
#define G8_WAIT_V(n) asm volatile("s_waitcnt vmcnt(" #n ")" ::: "memory")
#define G8_WAIT_L(n) asm volatile("s_waitcnt lgkmcnt(" #n ")" ::: "memory")
#define G8_BAR __builtin_amdgcn_s_barrier()
#define G8_SCHED __builtin_amdgcn_sched_barrier(0)
  int ui = 0;
  int t0 = blockIdx.x;
  if (t0 >= ntiles) return;
  int cpm, cpn; tile_map(t0, nM, nN, cpm, cpn);
  f32x4 acc[2][2][4][2];
#pragma unroll
  for (int a = 0; a < 2; ++a)
#pragma unroll
    for (int b = 0; b < 2; ++b)
#pragma unroll
      for (int m = 0; m < 4; ++m)
#pragma unroll
        for (int n = 0; n < 2; ++n) acc[a][b][m][n] = (f32x4){0.f, 0.f, 0.f, 0.f};
  bf16x8 At[4][2], B0[2][2], B1[2][2];
  const bool csw = E.swapped(cpn);
  const char* cA = csw ? Bbase + (size_t)cpn * tstep : Abase + (size_t)cpm * tstep;
  const char* cB = csw ? Abase + (size_t)cpm * tstep : Bbase + (size_t)cpn * tstep;
  G8_STAGE(G8_SB(0, 0), cB); G8_STAGE(G8_SA(0, 0), cA); G8_STAGE(G8_SB(0, 1), cB + hstep); G8_STAGE(G8_SA(0, 1), cA + hstep);
  if (wr == 1) G8_BAR;
  G8_WAIT_V(4); G8_BAR;
  G8_STAGE(G8_SB(1, 0), cB + kstep); G8_STAGE(G8_SA(1, 0), cA + kstep); G8_STAGE(G8_SB(1, 1), cB + hstep + kstep);
  G8_WAIT_V(6); G8_BAR;
  for (;;) {
    const int tn = blockIdx.x + (ui + 1) * gridDim.x;
    const bool has_next = tn < ntiles;
    int npm = cpm, npn = cpn;
    if (has_next) tile_map(tn, nM, nN, npm, npn);
    const bool nsw = has_next && E.swapped(npn);
    const char* nA = has_next ? (nsw ? Bbase + (size_t)npn * tstep : Abase + (size_t)npm * tstep) : cA;
    const char* nB = has_next ? (nsw ? Abase + (size_t)npm * tstep : Bbase + (size_t)npn * tstep) : cB;
    for (int t = 0; t < nt; t += 2) {
      const bool last = (t == nt - 2);
      const char* a1 = cA + (size_t)(t + 1) * kstep;
      const char* a2 = last ? nA : cA + (size_t)(t + 2) * kstep; const char* b2 = last ? nB : cB + (size_t)(t + 2) * kstep;
      const char* a3 = a2 + kstep; const char* b3 = b2 + kstep;
      G8_LDB(B0, 0, 0); G8_SCHED; G8_LDA(At, 0, 0); G8_STAGE(G8_SA(1, 1), a1 + hstep);
      G8_WAIT_L(8); G8_BAR; G8_WAIT_L(0); G8_MMA(0, 0, At, B0); G8_BAR; G8_SCHED;
      G8_LDB(B1, 0, 1); G8_STAGE(G8_SB(0, 0), b2);
      G8_BAR; G8_WAIT_L(0); G8_MMA(0, 1, At, B1); G8_BAR;
      G8_LDA(At, 0, 1); G8_STAGE(G8_SA(0, 0), a2);
      G8_BAR; G8_WAIT_L(0); G8_MMA(1, 0, At, B0); G8_BAR; G8_SCHED;
      G8_STAGE(G8_SB(0, 1), b2 + hstep);
      G8_WAIT_V(6); G8_BAR; G8_MMA(1, 1, At, B1); G8_BAR;
      G8_LDB(B0, 1, 0); G8_SCHED; G8_LDA(At, 1, 0); G8_STAGE(G8_SA(0, 1), a2 + hstep);
      G8_WAIT_L(8); G8_BAR; G8_WAIT_L(0); G8_MMA(0, 0, At, B0); G8_BAR; G8_SCHED;
      G8_LDB(B1, 1, 1); G8_STAGE(G8_SB(1, 0), b3);
      G8_BAR; G8_WAIT_L(0); G8_MMA(0, 1, At, B1); G8_BAR;
      G8_LDA(At, 1, 1); G8_STAGE(G8_SA(1, 0), a3);
      G8_BAR; G8_WAIT_L(0); G8_MMA(1, 0, At, B0); G8_BAR; G8_SCHED;
      G8_STAGE(G8_SB(1, 1), b3 + hstep);
      G8_WAIT_V(6); G8_BAR; G8_MMA(1, 1, At, B1); G8_BAR;
    }
    { int fr2 = fr, fq2 = fq; asm volatile("" : "+v"(fr2), "+v"(fq2));
      E(acc, cpm, cpn, wr, wc, fr2, fq2); }
    if (!has_next) break;
#pragma unroll
    for (int a = 0; a < 2; ++a)
#pragma unroll
      for (int b = 0; b < 2; ++b)
#pragma unroll
        for (int m = 0; m < 4; ++m)
#pragma unroll
          for (int n = 0; n < 2; ++n) acc[a][b][m][n] = (f32x4){0.f, 0.f, 0.f, 0.f};
    cpm = npm; cpn = npn; cA = nA; cB = nB; ++ui;
  }
  G8_WAIT_V(0);
  if (wr == 0) G8_BAR;
  G8_BAR;
#undef G8_SA
#undef G8_SB
#undef G8_STAGE
#undef G8_LDA
#undef G8_LDB
#undef G8_MMA
#undef G8_WAIT_V
#undef G8_WAIT_L
#undef G8_BAR
#undef G8_SCHED
}

typedef f32x4 acc_t[2][2][4][2];
typedef unsigned u32x2 __attribute__((ext_vector_type(2)));

struct EpiUp {
  char* hid;
  __device__ __forceinline__ bool swapped(int) const { return false; }
  __device__ __forceinline__ void operator()(const acc_t& acc, int pm, int pn, int wr, int wc, int fr, int fq) const {
    const unsigned lo = (unsigned)(fr * DFF + fq * 8) * 2u;
#pragma unroll
    for (int ai = 0; ai < 2; ++ai)
#pragma unroll
      for (int m = 0; m < 4; ++m) {
        const size_t ub = ((size_t)(pm * 256 + ai * 128 + wr * 64 + m * 16) * DFF + pn * 256 + wc * 32) * 2;
#pragma unroll
        for (int bj = 0; bj < 2; ++bj) {
          const f32x4 v0 = acc[ai][bj][m][0], v1 = acc[ai][bj][m][1];
          float r[8] = {fmaxf(v0[0], 0.f), fmaxf(v0[1], 0.f), fmaxf(v0[2], 0.f), fmaxf(v0[3], 0.f),
                        fmaxf(v1[0], 0.f), fmaxf(v1[1], 0.f), fmaxf(v1[2], 0.f), fmaxf(v1[3], 0.f)};
          uint4 pk;
          pk.x = cvtpk(r[0] * r[0], r[1] * r[1]); pk.y = cvtpk(r[2] * r[2], r[3] * r[3]);
          pk.z = cvtpk(r[4] * r[4], r[5] * r[5]); pk.w = cvtpk(r[6] * r[6], r[7] * r[7]);
          *(uint4*)(hid + ub + (bj * 128) * 2 + lo) = pk;
        }
      }
  }
};

struct EpiRes {
  const char* src; char* dst; const char* gate; int tok0;
  __device__ __forceinline__ bool swapped(int) const { return false; }
  __device__ __forceinline__ void operator()(const acc_t& acc, int pm, int pn, int wr, int wc, int fr, int fq) const {
    const unsigned lo = (unsigned)(fr * D + fq * 4) * 4u;
    const unsigned lg = (unsigned)(fq * 4) * 4u;
    const int b = (tok0 + pm * 256) / S;
    const size_t ug = ((size_t)b * 6144 + pn * 256 + wc * 32) * 4;
    float4 g[4];
#pragma unroll
    for (int q = 0; q < 4; ++q) g[q] = *(const float4*)(gate + ug + ((q >> 1) * 128 + (q & 1) * 16) * 4 + lg);
    const size_t ub0 = ((size_t)(tok0 + pm * 256 + wr * 64) * D + pn * 256 + wc * 32) * 4;
#pragma unroll
    for (int hb = 0; hb < 4; ++hb) {
      const int ai = hb >> 1, m0 = (hb & 1) * 2;
      float4 xb[2][4];
#pragma unroll
      for (int mm = 0; mm < 2; ++mm)
#pragma unroll
        for (int q = 0; q < 4; ++q)
          xb[mm][q] = *(const float4*)(src + ub0 + (size_t)(ai * 128 + (m0 + mm) * 16) * D * 4 + ((q >> 1) * 128 + (q & 1) * 16) * 4 + lo);
      __builtin_amdgcn_sched_barrier(0);
#pragma unroll
      for (int mm = 0; mm < 2; ++mm)
#pragma unroll
        for (int q = 0; q < 4; ++q) {
          const f32x4 v = acc[ai][q >> 1][m0 + mm][q & 1];
          float4 o = xb[mm][q];
          o.x += g[q].x * v[0]; o.y += g[q].y * v[1]; o.z += g[q].z * v[2]; o.w += g[q].w * v[3];
          *(float4*)(dst + ub0 + (size_t)(ai * 128 + (m0 + mm) * 16) * D * 4 + ((q >> 1) * 128 + (q & 1) * 16) * 4 + lo) = o;
        }
      __builtin_amdgcn_sched_barrier(0);
    }
  }
};

struct EpiIn {
  char* ws; const float* gq; const float* gk;
  __device__ __forceinline__ bool swapped(int pn) const { return (pn >= 8 && pn < 12) || (pn >= 16 && pn < 20); }
  __device__ __forceinline__ void operator()(const acc_t& acc, int pm, int pn, int wr, int wc, int fr, int fq) const {
    const int brow = pm * 256, b = brow / S, sb = brow % S;
    const int fqp = (fq == 1) ? 2 : (fq == 2) ? 1 : fq;
    const int frp = (((fr >> 2) == 1) ? 2 : ((fr >> 2) == 2) ? 1 : (fr >> 2)) * 4 + (fr & 3);
    if (pn < 8) {
      const bool isk = pn >= 4;
      const int hm = (((pn * 256) & 1023) >> 6) + wc;
      const char* gain = (const char*)(isk ? gk : gq);
      char* dst = ws + (isk ? OFF_KA : OFF_QA);
      const char* tab = ws + OFF_TABA;
      const unsigned lo_q = (unsigned)(fr * 64 + fq * 4) * 2u;
      const unsigned lo_t = (unsigned)(fr * 32 + fq * 4) * 8u;
      const unsigned lo_g = (unsigned)(fq * 4) * 4u;
      float4 gl4[2], gh4[2];
#pragma unroll
      for (int n = 0; n < 2; ++n) { gl4[n] = *(const float4*)(gain + n * 64 + lo_g); gh4[n] = *(const float4*)(gain + 128 + n * 64 + lo_g); }
      float4 tb[2][4];
      const int su0 = sb + wr * 64;
#pragma unroll
      for (int q = 0; q < 4; ++q) tb[0][q] = *(const float4*)(tab + ((size_t)su0 * 32 + (q >> 1) * 16) * 8 + (q & 1) * 16 + lo_t);
#pragma unroll
      for (int it = 0; it < 8; ++it) {
        const int ai = it >> 2, m = it & 3;
        if (it + 1 < 8) {
          const int sun = su0 + ((it + 1) >> 2) * 128 + ((it + 1) & 3) * 16;
#pragma unroll
          for (int q = 0; q < 4; ++q) tb[(it + 1) & 1][q] = *(const float4*)(tab + ((size_t)sun * 32 + (q >> 1) * 16) * 8 + (q & 1) * 16 + lo_t);
        }
        __builtin_amdgcn_sched_barrier(0);
        const int su = su0 + ai * 128 + m * 16;
        float ss = 0.f;
#pragma unroll
        for (int bj = 0; bj < 2; ++bj)
#pragma unroll
          for (int n = 0; n < 2; ++n)
#pragma unroll
            for (int j = 0; j < 4; ++j) ss += acc[ai][bj][m][n][j] * acc[ai][bj][m][n][j];
        ss += __shfl_xor(ss, 16);
        ss += __shfl_xor(ss, 32);
        float rstd = rsqrtf(ss * (1.f / 64.f) + EPS);
        if (!isk) rstd *= 0.125f * 1.4426950408889634f;
        const size_t ub = (((size_t)(b * 16 + hm) * S + su) * 64) * 2;
#pragma unroll
        for (int n = 0; n < 2; ++n) {
          const float4 c01 = tb[it & 1][n * 2], c23 = tb[it & 1][n * 2 + 1];
          const float cs[4] = {c01.x, c01.z, c23.x, c23.z}, sn[4] = {c01.y, c01.w, c23.y, c23.w};
          const float gl[4] = {gl4[n].x, gl4[n].y, gl4[n].z, gl4[n].w}, gh[4] = {gh4[n].x, gh4[n].y, gh4[n].z, gh4[n].w};
          float o1[4], o2[4];
#pragma unroll
          for (int j = 0; j < 4; ++j) {
            const float x1 = acc[ai][0][m][n][j] * rstd * gl[j], x2 = acc[ai][1][m][n][j] * rstd * gh[j];
            o1[j] = x1 * cs[j] - x2 * sn[j];
            o2[j] = x2 * cs[j] + x1 * sn[j];
          }
          uint2 k1, k2;
          k1.x = cvtpk(o1[0], o1[1]); k1.y = cvtpk(o1[2], o1[3]);
          k2.x = cvtpk(o2[0], o2[1]); k2.y = cvtpk(o2[2], o2[3]);
          *(uint2*)(dst + ub + n * 32 + lo_q) = k1;
          *(uint2*)(dst + ub + 64 + n * 32 + lo_q) = k2;
        }
        __builtin_amdgcn_sched_barrier(0);
      }
    } else if ((pn >= 8 && pn < 12) || (pn >= 16 && pn < 20)) {
      const bool isr = pn >= 16;
      const int cb = (isr ? pn * 256 - 4096 : pn * 256 - 2048) + wr * 64;
      char* dst = ws + (isr ? OFF_VRT : OFF_VAT);
      const unsigned lo = (unsigned)(fr * S + (isr ? fqp * 4 : fq * 8)) * 2u;
#pragma unroll
      for (int ai = 0; ai < 2; ++ai)
#pragma unroll
        for (int m = 0; m < 4; ++m) {
          const size_t ub = (((size_t)b * 1024 + cb + ai * 128 + m * 16) * S + sb + wc * 32) * 2;
#pragma unroll
          for (int bj = 0; bj < 2; ++bj) {
            if (isr) {
#pragma unroll
              for (int n = 0; n < 2; ++n) {
                const f32x4 v = acc[ai][bj][m][n];
                uint2 pk; pk.x = cvtpk(v[0], v[1]); pk.y = cvtpk(v[2], v[3]);
                *(uint2*)(dst + ub + (bj * 128 + n * 16) * 2 + lo) = pk;
              }
            } else {
              const f32x4 v0 = acc[ai][bj][m][0], v1 = acc[ai][bj][m][1];
              uint4 pk; pk.x = cvtpk(v0[0], v0[1]); pk.y = cvtpk(v0[2], v0[3]); pk.z = cvtpk(v1[0], v1[1]); pk.w = cvtpk(v1[2], v1[3]);
              *(uint4*)(dst + ub + (bj * 128) * 2 + lo) = pk;
            }
          }
          __builtin_amdgcn_sched_barrier(0);
        }
    } else if (pn < 16) {
      const bool isk = pn >= 14;
      const int h = ((((pn * 256) - 3072) & 511) >> 7) + (wc >> 1), w1 = wc & 1;
      const float scl = isk ? 0.08838834764831845f : 1.f;
      char* dst = ws + (isk ? OFF_KR : OFF_QR);
      char* dstT = ws + OFF_KRT;
      const char* tab = ws + OFF_TABR;
      const unsigned lo_q = (unsigned)(fr * 128 + fqp * 4) * 2u;
      const unsigned lo_t = (unsigned)(fr * 64 + fq * 4) * 8u;
      const unsigned lo_T = (unsigned)((fq * 4) * S + frp) * 2u;
      const float lg2 = __log2f(1.f - exp2f(-5.f - (float)h));
      float4 tb[2][4];
      const int su0 = sb + wr * 64;
#pragma unroll
      for (int q = 0; q < 4; ++q) tb[0][q] = *(const float4*)(tab + ((size_t)su0 * 64 + w1 * 32 + (q >> 1) * 16) * 8 + (q & 1) * 16 + lo_t);
#pragma unroll
      for (int it = 0; it < 8; ++it) {
        const int ai = it >> 2, m = it & 3;
        if (it + 1 < 8) {
          const int sun = su0 + ((it + 1) >> 2) * 128 + ((it + 1) & 3) * 16;
#pragma unroll
          for (int q = 0; q < 4; ++q) tb[(it + 1) & 1][q] = *(const float4*)(tab + ((size_t)sun * 64 + w1 * 32 + (q >> 1) * 16) * 8 + (q & 1) * 16 + lo_t);
        }
        __builtin_amdgcn_sched_barrier(0);
        const int su = su0 + ai * 128 + m * 16;
        const size_t ub = (((size_t)(b * 4 + h) * S + su) * 128 + w1 * 32) * 2;
        const size_t ubT = (((size_t)(b * 4 + h) * 128 + w1 * 32) * S + su) * 2;
        const float dec = exp2f((float)(63 - ((su & 63) + fr)) * lg2);
#pragma unroll
        for (int n = 0; n < 2; ++n) {
          const float4 c01 = tb[it & 1][n * 2], c23 = tb[it & 1][n * 2 + 1];
          const float cs[4] = {c01.x, c01.z, c23.x, c23.z}, sn[4] = {c01.y, c01.w, c23.y, c23.w};
          float o1[4], o2[4];
#pragma unroll
          for (int j = 0; j < 4; ++j) {
            const float x1 = acc[ai][0][m][n][j], x2 = acc[ai][1][m][n][j];
            o1[j] = (x1 * cs[j] - x2 * sn[j]) * scl;
            o2[j] = (x2 * cs[j] + x1 * sn[j]) * scl;
          }
          uint2 k1, k2;
          k1.x = cvtpk(o1[0], o1[1]); k1.y = cvtpk(o1[2], o1[3]);
          k2.x = cvtpk(o2[0], o2[1]); k2.y = cvtpk(o2[2], o2[3]);
          *(uint2*)(dst + ub + n * 32 + lo_q) = k1;
          *(uint2*)(dst + ub + 128 + n * 32 + lo_q) = k2;
          if (isk) {
#pragma unroll
            for (int j = 0; j < 4; ++j) {
              *(bf16_t*)(dstT + ubT + (size_t)(n * 16 + j) * (S * 2) + lo_T) = (bf16_t)(cvtpk(o1[j] * dec, 0.f) & 0xffffu);
              *(bf16_t*)(dstT + ubT + (size_t)(64 + n * 16 + j) * (S * 2) + lo_T) = (bf16_t)(cvtpk(o2[j] * dec, 0.f) & 0xffffu);
            }
          }
        }
        __builtin_amdgcn_sched_barrier(0);
      }
    } else {
      const bool ism = pn >= 24;
      const int cb = (ism ? pn * 256 - 6144 : pn * 256 - 5120) + wc * 32;
      char* dst = ws + (ism ? OFF_MGT : OFF_SG);
      const int ldd = ism ? 2048 : 1024;
      const unsigned lo = (unsigned)(fr * ldd + fq * 8) * 2u;
#pragma unroll
      for (int ai = 0; ai < 2; ++ai)
#pragma unroll
        for (int m = 0; m < 4; ++m) {
          const size_t ub = ((size_t)(brow + ai * 128 + wr * 64 + m * 16) * ldd + cb) * 2;
#pragma unroll
          for (int bj = 0; bj < 2; ++bj) {
            float o[8];
#pragma unroll
            for (int q = 0; q < 8; ++q) {
              const float v = acc[ai][bj][m][q >> 2][q & 3];
              const float sgm = 1.f / (1.f + __expf(-v));
              o[q] = ism ? sgm : v * sgm;
            }
            uint4 pk;
            pk.x = cvtpk(o[0], o[1]); pk.y = cvtpk(o[2], o[3]); pk.z = cvtpk(o[4], o[5]); pk.w = cvtpk(o[6], o[7]);
            *(uint4*)(dst + ub + (bj * 128) * 2 + lo) = pk;
          }
          __builtin_amdgcn_sched_barrier(0);
        }
    }
  }
};

typedef float f32x16 __attribute__((ext_vector_type(16)));
typedef int i32x4 __attribute__((ext_vector_type(4)));

__device__ __forceinline__ void attn_item(const P& p, LAS char* lds, int b, int h, int qt, float lam, float shift, const int wv) {
  const int tid = opaque_tid(wv), lane = tid & 63, wid = __builtin_amdgcn_readfirstlane(tid >> 6);
  const int r = lane & 31, hh = lane >> 5;
  const char* qa = (const char*)(p.ws + OFF_QA);
  const char* ka = (const char*)(p.ws + OFF_KA);
  const char* vaT = (const char*)(p.ws + OFF_VAT);
  const int q0 = qt * 256 + wid * 32;
  const int mychunk = qt * 4 + (wid >> 1);
  const int ntile = qt * 4 + 4;
  const int srow = tid >> 3, spc = tid & 7, sc = spc ^ ((srow >> 1) & 7);
  const unsigned klo = (unsigned)(srow * 64 + sc * 8) * 2u;
  const unsigned vlo = (unsigned)(srow * S + sc * 8) * 2u;
  const size_t kub0 = (((size_t)(b * 16 + h * 2) * S) * 64) * 2;
  const size_t vub0 = (((size_t)b * 1024 + h * 128) * S) * 2;
  LAS char* sdst = lds + wid * 1024;
  {
    const size_t qub = (((size_t)(b * 16 + h * 2) * S + qt * 256) * 64) * 2;
#pragma unroll
    for (int m_ = 0; m_ < 2; ++m_)
#pragma unroll
      for (int i_ = 0; i_ < 4; ++i_)
        __builtin_amdgcn_global_load_lds((const unsigned*)(qa + qub + (size_t)m_ * (S * 64 * 2) + (size_t)i_ * (64 * 64 * 2) + klo),
                                         (LAS unsigned*)(sdst + 65536 + m_ * 32768 + i_ * 8192), 16, 0, 0);
  }
#define ATT_STAGE(kt, bufoff) do { \
    _Pragma("unroll") for (int m_ = 0; m_ < 2; ++m_) \
      __builtin_amdgcn_global_load_lds((const unsigned*)(ka + kub0 + (size_t)m_ * (S * 64 * 2) + (size_t)(kt) * (64 * 64 * 2) + klo), \
                                       (LAS unsigned*)(sdst + (bufoff) + m_ * 8192), 16, 0, 0); \
    _Pragma("unroll") for (int i_ = 0; i_ < 2; ++i_) \
      __builtin_amdgcn_global_load_lds((const unsigned*)(vaT + vub0 + (size_t)i_ * (64 * S * 2) + (size_t)(kt) * (64 * 2) + vlo), \
                                       (LAS unsigned*)(sdst + (bufoff) + 16384 + i_ * 8192), 16, 0, 0); \
  } while (0)

  const int fr = lane & 15, fq = lane >> 4;
  f32x4 O[2][2][8];
#pragma unroll
  for (int m = 0; m < 2; ++m)
#pragma unroll
    for (int qb = 0; qb < 2; ++qb)
#pragma unroll
      for (int d = 0; d < 8; ++d) O[m][qb][d] = (f32x4){0.f, 0.f, 0.f, 0.f};
  float l[2][2] = {{0.f, 0.f}, {0.f, 0.f}};
  f32x4 cinit = (f32x4){-shift, -shift, -shift, -shift};
  asm volatile("" : "+v"(cinit));
  int ko[2];
#pragma unroll
  for (int ks = 0; ks < 2; ++ks) ko[ks] = fr * 128 + (((4 * ks + fq) ^ (fr >> 1)) * 16);

  ATT_STAGE(0, 0);
  for (int kt = 0; kt < ntile; ++kt) {
    asm volatile("s_waitcnt vmcnt(0)" ::: "memory");
    __syncthreads();
    if (kt + 1 < ntile) ATT_STAGE(kt + 1, ((kt + 1) & 1) * 32768);
    if (kt <= mychunk) {
      LAS char* cb = lds + (kt & 1) * 32768;
      LAS char* qbase = lds + 65536 + wid * 4096;
      bf16x8 pf[2][2][2], kf[8], qf[9], vf[16];
#define LD_K16(m_, q_) (*(const LAS bf16x8*)(cb + (m_) * 8192 + ((q_) & 3) * 2048 + ko[(q_) >> 2]))
#define LD_Q16(i_) (*(const LAS bf16x8*)(qbase + ((i_) >> 2) * 32768 + (((i_) >> 1) & 1) * 2048 + ko[(i_) & 1]))
#define LD_V16(q_) (*(const LAS bf16x8*)(cb + 16384 + ((q_) >> 1) * 2048 + ko[(q_) & 1]))
#pragma unroll
      for (int q = 0; q < 8; ++q) kf[q] = LD_K16(0, q);
      qf[0] = LD_Q16(0);
#pragma unroll
      for (int m = 0; m < 2; ++m) {
#pragma unroll
        for (int qb = 0; qb < 2; ++qb) {
          f32x4 s[4];
#pragma unroll
          for (int ks = 0; ks < 2; ++ks) {
            const int i = m * 4 + qb * 2 + ks;
            if (i + 1 < 8) qf[i + 1] = LD_Q16(i + 1);
            __builtin_amdgcn_sched_barrier(0);
            __builtin_amdgcn_s_setprio(1);
#pragma unroll
            for (int kb = 0; kb < 4; ++kb)
              s[kb] = __builtin_amdgcn_mfma_f32_16x16x32_bf16(kf[ks * 4 + kb], qf[i], ks == 0 ? cinit : s[kb], 0, 0, 0);
            __builtin_amdgcn_s_setprio(0);
            __builtin_amdgcn_sched_barrier(0);
          }
          if (qb == 1 && m == 0) {
#pragma unroll
            for (int q = 0; q < 8; ++q) kf[q] = LD_K16(1, q);
          }
          if (qb == 1 && m == 1) { vf[0] = LD_V16(0); vf[1] = LD_V16(1); vf[2] = LD_V16(2); }
          __builtin_amdgcn_sched_barrier(0);
          float ls = 0.f;
#pragma unroll
          for (int kb = 0; kb < 4; ++kb)
#pragma unroll
            for (int e = 0; e < 4; ++e) { s[kb][e] = __builtin_amdgcn_exp2f(s[kb][e]); ls += s[kb][e]; }
          l[m][qb] += ls;
#pragma unroll
          for (int t = 0; t < 2; ++t) {
            i32x4 pk;
            pk[0] = (int)cvtpk(s[2 * t][0], s[2 * t][1]); pk[1] = (int)cvtpk(s[2 * t][2], s[2 * t][3]);
            pk[2] = (int)cvtpk(s[2 * t + 1][0], s[2 * t + 1][1]); pk[3] = (int)cvtpk(s[2 * t + 1][2], s[2 * t + 1][3]);
            pf[m][qb][t] = __builtin_bit_cast(bf16x8, pk);
          }
          __builtin_amdgcn_sched_barrier(0);
        }
      }
#pragma unroll
      for (int q = 0; q < 16; ++q) {
        if (q + 3 < 16) vf[q + 3] = LD_V16(q + 3);
        __builtin_amdgcn_sched_barrier(0);
        __builtin_amdgcn_s_setprio(1);
#pragma unroll
        for (int m = 0; m < 2; ++m)
#pragma unroll
          for (int qb = 0; qb < 2; ++qb)
            O[m][qb][q >> 1] = __builtin_amdgcn_mfma_f32_16x16x32_bf16(vf[q], pf[m][qb][q & 1], O[m][qb][q >> 1], 0, 0, 0);
        __builtin_amdgcn_s_setprio(0);
        __builtin_amdgcn_sched_barrier(0);
      }
#undef LD_K16
#undef LD_Q16
#undef LD_V16
    }
  }
#undef ATT_STAGE
  {
    const char* mg = (const char*)(p.ws + OFF_MGT);
    char* u = (char*)(p.ws + OFF_U);
    const char* gda = (const char*)p.gda;
#pragma unroll
    for (int qb = 0; qb < 2; ++qb) {
      float l0 = l[0][qb], l1 = l[1][qb];
      l0 += __shfl_xor(l0, 16); l0 += __shfl_xor(l0, 32);
      l1 += __shfl_xor(l1, 16); l1 += __shfl_xor(l1, 32);
      const float i0 = 1.f / l0, i1 = lam / l1;
      float ss = 0.f;
#pragma unroll
      for (int d = 0; d < 8; ++d)
#pragma unroll
        for (int e = 0; e < 4; ++e) {
          const float v = O[0][qb][d][e] * i0 - O[1][qb][d][e] * i1;
          O[0][qb][d][e] = v;
          ss += v * v;
        }
      ss += __shfl_xor(ss, 16);
      ss += __shfl_xor(ss, 32);
      const float rstd = rsqrtf(ss * (1.f / 128.f) + EPS) * 0.8f;
      const size_t ub = (((size_t)b * S + q0 + qb * 16) * 2048 + h * 128) * 2;
      const unsigned lo = (unsigned)(fr * 2048 + fq * 4) * 2u;
      const size_t ubu = (((size_t)b * S + q0 + qb * 16) * 1024 + h * 128) * 2;
      const unsigned lou = (unsigned)(fr * 1024 + fq * 4) * 2u;
#pragma unroll
      for (int d = 0; d < 8; ++d) {
        const uint2 gm = *(const uint2*)(mg + ub + d * 32 + lo);
        const float4 gd = *(const float4*)(gda + d * 64 + fq * 16);
        const float g0 = __uint_as_float(gm.x << 16), g1 = __uint_as_float(gm.x & 0xffff0000u);
        const float g2 = __uint_as_float(gm.y << 16), g3 = __uint_as_float(gm.y & 0xffff0000u);
        uint2 pk;
        pk.x = cvtpk(O[0][qb][d][0] * rstd * gd.x * g0, O[0][qb][d][1] * rstd * gd.y * g1);
        pk.y = cvtpk(O[0][qb][d][2] * rstd * gd.z * g2, O[0][qb][d][3] * rstd * gd.w * g3);
        *(uint2*)(u + ubu + d * 32 + lou) = pk;
      }
    }
  }
}

__device__ __forceinline__ void ret_scan_item(const P& p, LAS char* lds, int b, int h, const int wv) {
  const int tid = opaque_tid(wv), lane = tid & 63, wid = __builtin_amdgcn_readfirstlane(tid >> 6);
  const int r = lane & 31, hh = lane >> 5;
  const float lg2 = __log2f(1.f - exp2f(-5.f - (float)h));
  const char* krT = (const char*)(p.ws + OFF_KRT);
  const char* vrT = (const char*)(p.ws + OFF_VRT);
  char* snap = (char*)(p.ws + OFF_SNAP);
  const int trow = tid >> 3, tc = (tid & 7) ^ ((trow >> 1) & 7);
  const unsigned ktlo = (unsigned)(trow * S + tc * 8) * 2u;
  const size_t ktub = (((size_t)(b * 4 + h) * 128) * S) * 2;
  LAS char* sdst = lds + wid * 1024;
#define SCAN_STAGE(c0, bufoff) do { \
    _Pragma("unroll") for (int i_ = 0; i_ < 2; ++i_) \
      __builtin_amdgcn_global_load_lds((const unsigned*)(krT + ktub + (size_t)i_ * (64 * S * 2) + (size_t)(c0) * 128 + ktlo), \
                                       (LAS unsigned*)(sdst + (bufoff) + i_ * 8192), 16, 0, 0); \
  } while (0)
  int ft4[4];
#pragma unroll
  for (int st = 0; st < 4; ++st) ft4[st] = r * 128 + (((2 * st + hh) ^ ((r >> 1) & 7)) * 16);
  const unsigned vlo = (unsigned)(r * S + hh * 8) * 2u;
  const size_t vub = (((size_t)(b * 4 + h) * 256 + wid * 32) * S) * 2;
  const size_t sub = ((size_t)(b * 4 + h) * 64) * 65536 + (size_t)wid * 8192;
  f32x16 st_[4];
#pragma unroll
  for (int d = 0; d < 4; ++d)
#pragma unroll
    for (int e = 0; e < 16; ++e) st_[d][e] = 0.f;
  const float g64 = exp2f(64.f * lg2);
  bf16x8 vf[4], vfn[4];
  SCAN_STAGE(0, 0);
#pragma unroll
  for (int st = 0; st < 4; ++st) vf[st] = *(const bf16x8*)(vrT + vub + st * 32 + vlo);
  for (int c = 0; c < 64; ++c) {
    asm volatile("s_waitcnt vmcnt(0)" ::: "memory");
    __syncthreads();
    if (c + 1 < 64) {
      SCAN_STAGE(c + 1, ((c + 1) & 1) * 16384);
#pragma unroll
      for (int st = 0; st < 4; ++st) vfn[st] = *(const bf16x8*)(vrT + vub + (size_t)(c + 1) * 128 + st * 32 + vlo);
    }
#pragma unroll
    for (int d = 0; d < 4; ++d)
#pragma unroll
      for (int s2 = 0; s2 < 2; ++s2) {
        i32x4 pk;
        pk[0] = (int)cvtpk(st_[d][8 * s2 + 0], st_[d][8 * s2 + 1]);
        pk[1] = (int)cvtpk(st_[d][8 * s2 + 2], st_[d][8 * s2 + 3]);
        pk[2] = (int)cvtpk(st_[d][8 * s2 + 4], st_[d][8 * s2 + 5]);
        pk[3] = (int)cvtpk(st_[d][8 * s2 + 6], st_[d][8 * s2 + 7]);
        *(i32x4*)(snap + sub + (size_t)c * 65536 + (d * 2 + s2) * 1024 + lane * 16) = pk;
      }
    LAS char* cb = lds + (c & 1) * 16384;
#pragma unroll
    for (int d = 0; d < 4; ++d) {
#pragma unroll
      for (int e = 0; e < 16; ++e) st_[d][e] *= g64;
#pragma unroll
      for (int st = 0; st < 4; ++st) {
        bf16x8 tf = *(const LAS bf16x8*)(cb + d * 4096 + ft4[st]);
        st_[d] = __builtin_amdgcn_mfma_f32_32x32x16_bf16(tf, vf[st], st_[d], 0, 0, 0);
      }
    }
#pragma unroll
    for (int st = 0; st < 4; ++st) vf[st] = vfn[st];
  }
#undef SCAN_STAGE
}

__device__ __forceinline__ void ret_out_item(const P& p, LAS char* lds, int b, int h, int c, const int wv) {
  const int tid = opaque_tid(wv), lane = tid & 63, wid = __builtin_amdgcn_readfirstlane(tid >> 6);
  const int r = lane & 31, hh = lane >> 5;
  const float lg2 = __log2f(1.f - exp2f(-5.f - (float)h));
  const char* qr = (const char*)(p.ws + OFF_QR);
  const char* kr = (const char*)(p.ws + OFF_KR);
  const char* vrT = (const char*)(p.ws + OFF_VRT);
  const char* sg = (const char*)(p.ws + OFF_SG);
  const char* mg = (const char*)(p.ws + OFF_MGT);
  const char* gret = (const char*)p.gret;
  const char* snap = (const char*)(p.ws + OFF_SNAP);
  char* u = (char*)(p.ws + OFF_U);
  const int qrow = tid >> 4, qc = (tid & 15) ^ (qrow & 15);
  const unsigned qklo = (unsigned)(qrow * 128 + qc * 8) * 2u;
  const size_t qkub = (((size_t)(b * 4 + h) * S + c * 64) * 128) * 2;
  LAS char* sdst = lds + wid * 1024;
#pragma unroll
  for (int i_ = 0; i_ < 2; ++i_) {
    __builtin_amdgcn_global_load_lds((const unsigned*)(qr + qkub + i_ * 8192 + qklo), (LAS unsigned*)(sdst + i_ * 8192), 16, 0, 0);
    __builtin_amdgcn_global_load_lds((const unsigned*)(kr + qkub + i_ * 8192 + qklo), (LAS unsigned*)(sdst + 16384 + i_ * 8192), 16, 0, 0);
  }
  int fq8[8];
#pragma unroll
  for (int st = 0; st < 8; ++st) fq8[st] = r * 256 + (((2 * st + hh) ^ (r & 15)) * 16);
  const unsigned vlo = (unsigned)(r * S + hh * 8) * 2u;
  const size_t vub = (((size_t)(b * 4 + h) * 256 + wid * 32) * S) * 2;
  bf16x8 vf[4];
#pragma unroll
  for (int st = 0; st < 4; ++st) vf[st] = *(const bf16x8*)(vrT + vub + (size_t)c * 128 + st * 32 + vlo);
  bf16x8 af[8];
  {
    const size_t sub = ((size_t)(b * 4 + h) * 64 + c) * 65536 + (size_t)wid * 8192;
#pragma unroll
    for (int q = 0; q < 8; ++q) af[q] = *(const bf16x8*)(snap + sub + q * 1024 + lane * 16);
  }
  LAS float* ssum = (LAS float*)(lds + 32768);
  const float gi0 = exp2f((float)(r + 1) * lg2), gi1 = exp2f((float)(r + 33) * lg2);
  asm volatile("s_waitcnt vmcnt(0)" ::: "memory");
  __syncthreads();
  LAS char* cb = lds;
  const int rr = r - 4 * hh;
  bf16x8 pf[3][2];
#pragma unroll
  for (int blk = 0; blk < 3; ++blk) {
    const int jb = (blk == 2) ? 1 : 0, ib = (blk == 0) ? 0 : 1;
    f32x16 sa;
#pragma unroll
    for (int e = 0; e < 16; ++e) sa[e] = 0.f;
#pragma unroll
    for (int st = 0; st < 8; ++st) {
      bf16x8 kf = *(const LAS bf16x8*)(cb + 16384 + jb * 8192 + fq8[st]);
      bf16x8 qf = *(const LAS bf16x8*)(cb + ib * 8192 + fq8[st]);
      sa = __builtin_amdgcn_mfma_f32_32x32x16_bf16(kf, qf, sa, 0, 0, 0);
    }
#pragma unroll
    for (int e = 0; e < 16; ++e) {
      const int dl = rr + (ib * 32 - jb * 32 - (e & 3) - 8 * (e >> 2));
      const float dcy = __builtin_amdgcn_exp2f((float)dl * lg2);
      sa[e] = (dl >= 0) ? sa[e] * dcy : 0.f;
    }
#pragma unroll
    for (int s2 = 0; s2 < 2; ++s2) {
      i32x4 pk;
      pk[0] = (int)cvtpk(sa[8 * s2 + 0], sa[8 * s2 + 1]);
      pk[1] = (int)cvtpk(sa[8 * s2 + 2], sa[8 * s2 + 3]);
      pk[2] = (int)cvtpk(sa[8 * s2 + 4], sa[8 * s2 + 5]);
      pk[3] = (int)cvtpk(sa[8 * s2 + 6], sa[8 * s2 + 7]);
      pf[blk][s2] = __builtin_bit_cast(bf16x8, pk);
    }
  }
  f32x16 Y[2];
#pragma unroll
  for (int ib = 0; ib < 2; ++ib)
#pragma unroll
    for (int e = 0; e < 16; ++e) Y[ib][e] = 0.f;
#pragma unroll
  for (int q = 0; q < 8; ++q)
#pragma unroll
    for (int ib = 0; ib < 2; ++ib) {
      bf16x8 qf = *(const LAS bf16x8*)(cb + ib * 8192 + fq8[q]);
      Y[ib] = __builtin_amdgcn_mfma_f32_32x32x16_bf16(af[q], qf, Y[ib], 0, 0, 0);
    }
#pragma unroll
  for (int e = 0; e < 16; ++e) { Y[0][e] *= gi0; Y[1][e] *= gi1; }
#pragma unroll
  for (int s2 = 0; s2 < 2; ++s2) {
    Y[0] = __builtin_amdgcn_mfma_f32_32x32x16_bf16(vf[s2], pf[0][s2], Y[0], 0, 0, 0);
    Y[1] = __builtin_amdgcn_mfma_f32_32x32x16_bf16(vf[s2], pf[1][s2], Y[1], 0, 0, 0);
    Y[1] = __builtin_amdgcn_mfma_f32_32x32x16_bf16(vf[2 + s2], pf[2][s2], Y[1], 0, 0, 0);
  }
  {
    float s0 = 0.f, s1 = 0.f;
#pragma unroll
    for (int e = 0; e < 16; ++e) { s0 += Y[0][e] * Y[0][e]; s1 += Y[1][e] * Y[1][e]; }
    s0 += __shfl_xor(s0, 32);
    s1 += __shfl_xor(s1, 32);
    LAS float* sp = ssum + wid * 64;
    if (hh == 0) { sp[r] = s0; sp[32 + r] = s1; }
    __syncthreads();
    float t0 = 0.f, t1 = 0.f;
#pragma unroll
    for (int w8 = 0; w8 < 8; ++w8) { t0 += ssum[w8 * 64 + r]; t1 += ssum[w8 * 64 + 32 + r]; }
    const float rs[2] = {rsqrtf(t0 * (1.f / 256.f) + EPS), rsqrtf(t1 * (1.f / 256.f) + EPS)};
#pragma unroll
    for (int ib = 0; ib < 2; ++ib) {
      const size_t tk = (size_t)b * S + c * 64 + ib * 32;
      const unsigned col0 = (unsigned)(h * 256 + wid * 32 + hh * 4);
#pragma unroll
      for (int g = 0; g < 4; ++g) {
        const unsigned col = col0 + g * 8;
        const uint2 sv = *(const uint2*)(sg + (tk * 1024 + col) * 2 + (unsigned)(r * 1024) * 2u);
        const uint2 gv = *(const uint2*)(mg + (tk * 2048 + 1024 + col) * 2 + (unsigned)(r * 2048) * 2u);
        const float4 gr = *(const float4*)(gret + (wid * 32 + g * 8 + hh * 4) * 4);
        const float a0 = __uint_as_float(sv.x << 16) * __uint_as_float(gv.x << 16);
        const float a1 = __uint_as_float(sv.x & 0xffff0000u) * __uint_as_float(gv.x & 0xffff0000u);
        const float a2 = __uint_as_float(sv.y << 16) * __uint_as_float(gv.y << 16);
        const float a3 = __uint_as_float(sv.y & 0xffff0000u) * __uint_as_float(gv.y & 0xffff0000u);
        char* up = u + (tk * 1024 + col) * 2 + (unsigned)(r * 1024) * 2u;
        const uint2 ua = *(const uint2*)up;
        uint2 pk;
        pk.x = cvtpk(__uint_as_float(ua.x << 16) + Y[ib][4 * g + 0] * rs[ib] * gr.x * a0, __uint_as_float(ua.x & 0xffff0000u) + Y[ib][4 * g + 1] * rs[ib] * gr.y * a1);
        pk.y = cvtpk(__uint_as_float(ua.y << 16) + Y[ib][4 * g + 2] * rs[ib] * gr.z * a2, __uint_as_float(ua.y & 0xffff0000u) + Y[ib][4 * g + 3] * rs[ib] * gr.w * a3);
        *(uint2*)up = pk;
      }
    }
  }
}

__device__ void ret_out_phase(const P& p, LAS char* lds, const int wv) {
  const int nitems = NB * 4 * 64;
  for (int it = blockIdx.x; it < nitems; it += gridDim.x) {
    __syncthreads();
    ret_out_item(p, lds, it >> 8, (it >> 6) & 3, it & 63, wv);
  }
}

__device__ void attn_fast(const P& p, LAS char* lds, int g, const int wv) {
  float lam;
  {
    float s1 = 0.f, s2 = 0.f;
    for (int i = 0; i < 64; ++i) { s1 += p.lq1[i] * p.lk1[i]; s2 += p.lq2[i] * p.lk2[i]; }
    lam = __expf(s1) - __expf(s2) + 0.2f;
  }
  unsigned* cnt = (unsigned*)(p.ws + OFF_CNT) + g;
  LAS volatile int* slot = (LAS volatile int*)(lds + 131072);
  float gqm = 0.f, gkm = 0.f;
  for (int i = 0; i < 64; ++i) { gqm = fmaxf(gqm, fabsf(p.gq[i])); gkm = fmaxf(gkm, fabsf(p.gk[i])); }
  const float shift = 8.f * 1.4426950408889634f * gqm * gkm;
  const int nret = NB * 4;
  const int nitems = nret + NB * 8 * 16;
  for (;;) {
    __syncthreads();
    if (opaque_tid(wv) == 0) *slot = (int)atomicAdd(cnt, 1u);
    __syncthreads();
    const int it = *slot;
    if (it >= nitems) break;
    if (it < nret) { ret_scan_item(p, lds, it >> 2, it & 3, wv); continue; }
    const int ia = it - nret;
    const int qt = 15 - ia / (NB * 8), bh = ia % (NB * 8);
    attn_item(p, lds, bh >> 3, bh & 7, qt, lam, shift, wv);
  }
}

__device__ __forceinline__ P load_params() {
#if defined(__HIP_DEVICE_COMPILE__)
  const __attribute__((address_space(4))) P* kp = (const __attribute__((address_space(4))) P*)__builtin_amdgcn_kernarg_segment_ptr();
  asm volatile("" : "+s"(kp));
  return *kp;
#else
  return P{};
#endif
}

#define XB_TMO      128
#define XB_XCNT(j)  (256  + 64 * (j))
#define XB_XSUB(j)  (1280 + 64 * (j))
#define XB_XGEN(j)  (2304 + 64 * (j))
#define XB_TOP      3328
#define XB_TOPGEN   3392
#define XB_SPIN_CAP (1u << 18)
__device__ __forceinline__ unsigned xb_ld(unsigned* p) { return __hip_atomic_load(p, __ATOMIC_RELAXED, __HIP_MEMORY_SCOPE_AGENT); }
__device__ __forceinline__ unsigned xb_add(unsigned* p, unsigned v) { return __hip_atomic_fetch_add(p, v, __ATOMIC_RELAXED, __HIP_MEMORY_SCOPE_AGENT); }
__device__ __forceinline__ unsigned xb_xcc_id() { return (unsigned)__builtin_amdgcn_s_getreg((3 << 11) | 20) & 0xFu; }
#define XB_SPIN(cond, bar) do { unsigned _sp = 0; while (cond) { __builtin_amdgcn_s_sleep(1); \
    if ((++_sp & 255u) == 0u) { if (xb_ld(&(bar)[XB_TMO])) break; if (_sp > XB_SPIN_CAP) { atomicAdd(&(bar)[XB_TMO], 1u); break; } } } } while (0)

__device__ __forceinline__ void xb_complete(unsigned* bar, unsigned x, unsigned& nloc, unsigned& nx) {
  const unsigned G = gridDim.x;
  unsigned sum, cnt, mine, sp = 0u;
  for (;;) {
    sum = 0u; cnt = 0u; mine = 0u;
#pragma unroll
    for (unsigned j = 0; j < 16; ++j) { const unsigned c = xb_ld(&bar[XB_XCNT(j)]); sum += c; cnt += (c > 0u) ? 1u : 0u; mine = (j == x) ? c : mine; }
    if (sum == G) break;
    __builtin_amdgcn_s_sleep(1);
    if ((++sp & 255u) == 0u) { if (xb_ld(&bar[XB_TMO])) break; if (sp > XB_SPIN_CAP) { atomicAdd(&bar[XB_TMO], 1u); break; } }
  }
  nloc = mine > 0u ? mine : 1u; nx = cnt > 0u ? cnt : 1u;
}

__device__ __forceinline__ void grid_bar(LAS char* lds, const int wv) {
  asm volatile("s_waitcnt vmcnt(0)" ::: "memory");
  __syncthreads();
  if (opaque_tid(wv) == 0) {
    unsigned* bar = (unsigned*)(load_params().ws + OFF_BAR);
    volatile LAS unsigned* st = (volatile LAS unsigned*)(lds + 131072 + 16);
    const unsigned x = xb_xcc_id();
    __builtin_amdgcn_s_waitcnt(0);
    unsigned nloc = st[0], nx = st[1];
    if (nloc == 0u) { xb_complete(bar, x, nloc, nx); st[0] = nloc; st[1] = nx; }
    const unsigned old = xb_add(&bar[XB_XSUB(x)], 1u);
    const unsigned gen = old / nloc;
    if (old + 1u == (gen + 1u) * nloc) {
      __builtin_amdgcn_fence(__ATOMIC_RELEASE, "agent");
      asm volatile("s_waitcnt vmcnt(0)" ::: "memory");
      const unsigned og = xb_add(&bar[XB_TOP], 1u);
      const unsigned tg = og / nx;
      if (og + 1u == (tg + 1u) * nx) xb_add(&bar[XB_TOPGEN], 1u);
      else XB_SPIN(xb_ld(&bar[XB_TOPGEN]) == tg, bar);
      __builtin_amdgcn_fence(__ATOMIC_ACQUIRE, "agent");
      xb_add(&bar[XB_XGEN(x)], 1u);
      asm volatile("s_waitcnt vmcnt(0)" ::: "memory");
    } else {
      XB_SPIN(xb_ld(&bar[XB_XGEN(x)]) == gen, bar);
      __builtin_amdgcn_fence(__ATOMIC_ACQUIRE, "agent");
      asm volatile("s_waitcnt vmcnt(0)" ::: "memory");
    }
  }
  __syncthreads();
}

__global__ void __launch_bounds__(NTHR) mega(P p_unused) {
  extern __shared__ __attribute__((aligned(16))) char smem_raw[];
  const int wv = __builtin_amdgcn_readfirstlane(threadIdx.x >> 6);
  cg::grid_group grid = cg::this_grid();
  LAS char* lds = (LAS char*)smem_raw;
  {
    const P p = load_params();
    float* sm = (float*)smem_raw;
    if (opaque_tid(wv) == 0) {
      volatile LAS unsigned* st = (volatile LAS unsigned*)(lds + 131072 + 16);
      st[0] = 0u; st[1] = 0u;
      (void)xb_add(&((unsigned*)(p.ws + OFF_BAR))[XB_XCNT(xb_xcc_id())], 1u);
    }
    phase_mod(p, sm, wv);
    transpose_w(p.w_in, 1024, INC, (bf16_t*)(p.ws + OFF_WIN), 1024, 0, sm, 1, wv);
    transpose_w(p.w_out, 1024, 1024, (bf16_t*)(p.ws + OFF_WOUT), 1024, 0, sm, 0, wv);
    transpose_w(p.w_up, 1024, DFF, (bf16_t*)(p.ws + OFF_WUP), 1024, 0, sm, 2, wv);
    transpose_w(p.w_down, DFF, 1024, (bf16_t*)(p.ws + OFF_WDN), DFF, 0, sm, 0, wv);
  }
  if (p_unused.ws == nullptr) grid.sync();
  grid_bar(lds, wv);
#pragma unroll 1
  for (int g = 0; g < NG; ++g) {
    {
      const P p = load_params();
      phase_norm(p.x, p.g1, (const float*)(p.ws + OFF_MOD), 0, 1024, (bf16_t*)(p.ws + OFF_HMIX), g * MG, MG, wv);
    }
    grid_bar(lds, wv);
    { const P p = load_params(); EpiIn e{p.ws, p.gq, p.gk}; gemm_phase(lds, p.ws + OFF_HMIX, p.ws + OFF_WIN, 1024, MG / 256, INC / 256, e, wv); }
    grid_bar(lds, wv);
    { const P p = load_params(); attn_fast(p, lds, g, wv); }
    grid_bar(lds, wv);
    { const P p = load_params(); ret_out_phase(p, lds, wv); }
    grid_bar(lds, wv);
    { const P p = load_params(); EpiRes e{(const char*)p.x, (char*)p.out, p.ws + OFF_MOD + 2048 * 4, g * MG}; gemm_phase(lds, p.ws + OFF_U, p.ws + OFF_WOUT, 1024, MG / 256, D / 256, e, wv); }
    if (g + 1 == NG) grid_bar(lds, wv);
  }
  {
    const P p = load_params();
    phase_norm(p.out, p.g2, (const float*)(p.ws + OFF_MOD), 3072, 4096, (bf16_t*)(p.ws + OFF_HFF), 0, MTOK, wv);
  }
  grid_bar(lds, wv);
  { const P p = load_params(); EpiUp e{p.ws + OFF_HID}; gemm_phase(lds, p.ws + OFF_HFF, p.ws + OFF_WUP, 1024, MTOK / 256, DFF / 256, e, wv); }
  grid_bar(lds, wv);
  { const P p = load_params(); EpiRes e{(const char*)p.out, (char*)p.out, p.ws + OFF_MOD + 5120 * 4, 0}; gemm_phase(lds, p.ws + OFF_HID, p.ws + OFF_WDN, DFF, MTOK / 256, D / 256, e, wv); }
}

extern "C" void kernel_launch(void* const* d_in, const int* in_sizes, int n_in, void* d_out, int out_size, void* d_ws,
                              size_t ws_size, hipStream_t stream) {
  static int grid_blocks = 0;
  if (!grid_blocks) {
    int dev = 0, cus = 0, per_cu = 0;
    hipGetDevice(&dev);
    hipDeviceGetAttribute(&cus, hipDeviceAttributeMultiprocessorCount, dev);
    hipFuncSetAttribute((const void*)mega, hipFuncAttributeMaxDynamicSharedMemorySize, (int)LDS_BYTES);
    hipOccupancyMaxActiveBlocksPerMultiprocessor(&per_cu, mega, NTHR, LDS_BYTES);
    if (per_cu < 1) per_cu = 1;
    if (per_cu > 1) per_cu = 1;
    grid_blocks = cus * per_cu;
  }
  P p{};
  p.x = (const float*)d_in[0]; p.c = (const float*)d_in[1]; p.w_ada = (const float*)d_in[2]; p.b_ada = (const float*)d_in[3];
  p.g1 = (const float*)d_in[4]; p.w_in = (const float*)d_in[5]; p.gq = (const float*)d_in[6]; p.gk = (const float*)d_in[7];
  p.lq1 = (const float*)d_in[8]; p.lk1 = (const float*)d_in[9]; p.lq2 = (const float*)d_in[10]; p.lk2 = (const float*)d_in[11];
  p.gda = (const float*)d_in[12]; p.gret = (const float*)d_in[13]; p.w_out = (const float*)d_in[14]; p.g2 = (const float*)d_in[15];
  p.w_up = (const float*)d_in[16]; p.w_down = (const float*)d_in[17];
  p.out = (float*)d_out; p.ws = (char*)d_ws;
  hipMemsetAsync((char*)d_ws + OFF_CNT, 0, (OFF_WIN - OFF_CNT), stream);
  void* args[] = {&p};
  hipError_t e = hipLaunchCooperativeKernel((const void*)mega, dim3(grid_blocks), dim3(NTHR), args, LDS_BYTES, stream);
  if (e != hipSuccess) fprintf(stderr, "cooperative launch failed: %s (grid %d)\n", hipGetErrorString(e), grid_blocks);
}
```

```cpp
#include <hip/hip_runtime.h>
#include <hip/hip_cooperative_groups.h>
#include <cstdio>
namespace cg = cooperative_groups;

typedef unsigned short bf16_t;
constexpr int D = 1024, NBATCH = 8, S = 4096, MTOK = NBATCH * S, DFF = 4096, INC = 8192;
constexpr int NB = 4;
constexpr int NG = NBATCH / NB;
constexpr int MG = NB * S;
constexpr float EPS = 1e-6f;
constexpr int NTHR = 512;
constexpr size_t LDS_BYTES = 144 * 1024;

struct P {
  const float *x, *c, *w_ada, *b_ada, *g1, *w_in, *gq, *gk, *lq1, *lk1, *lq2, *lk2, *gda, *gret, *w_out, *g2, *w_up, *w_down;
  float* out;
  char* ws;
};

constexpr size_t al(size_t x) { return (x + 255) & ~(size_t)255; }
constexpr size_t OFF_MOD = 0;
constexpr size_t OFF_TABA = al(OFF_MOD + 8 * 6144 * 4);
constexpr size_t OFF_TABR = al(OFF_TABA + 4096 * 32 * 8);
constexpr size_t OFF_CNT = al(OFF_TABR + 4096 * 64 * 8);
constexpr size_t OFF_BAR = al(OFF_CNT + 256);
constexpr size_t OFF_WIN = al(OFF_BAR + 3456 * 4);
constexpr size_t OFF_WOUT = al(OFF_WIN + (size_t)8192 * 1024 * 2);
constexpr size_t OFF_WUP = al(OFF_WOUT + (size_t)1024 * 2048 * 2);
constexpr size_t OFF_WDN = al(OFF_WUP + (size_t)4096 * 1024 * 2);
constexpr size_t OFF_GRP = al(OFF_WDN + (size_t)1024 * 4096 * 2);
constexpr size_t OFF_HMIX = OFF_GRP;
constexpr size_t OFF_QA = al(OFF_HMIX + (size_t)MG * 1024 * 2);
constexpr size_t OFF_KA = al(OFF_QA + (size_t)MG * 1024 * 2);
constexpr size_t OFF_VAT = al(OFF_KA + (size_t)MG * 1024 * 2);
constexpr size_t OFF_QR = al(OFF_VAT + (size_t)MG * 1024 * 2);
constexpr size_t OFF_KR = al(OFF_QR + (size_t)MG * 512 * 2);
constexpr size_t OFF_VRT = al(OFF_KR + (size_t)MG * 512 * 2);
constexpr size_t OFF_SG = al(OFF_VRT + (size_t)MG * 1024 * 2);
constexpr size_t OFF_MGT = al(OFF_SG + (size_t)MG * 1024 * 2);
constexpr size_t OFF_U = al(OFF_MGT + (size_t)MG * 2048 * 2);
constexpr size_t OFF_KRT = al(OFF_U + (size_t)MG * 2048 * 2);
constexpr size_t OFF_SNAP = al(OFF_KRT + (size_t)MG * 512 * 2);
constexpr size_t OFF_GRP_END = al(OFF_SNAP + (size_t)NB * 4 * 64 * 65536);
static_assert(OFF_GRP_END <= (size_t)512 * 1024 * 1024, "ws overflow");
constexpr size_t OFF_HFF = OFF_GRP;
constexpr size_t OFF_HID = al(OFF_HFF + (size_t)MTOK * 1024 * 2);
constexpr size_t OFF_FFN_END = al(OFF_HID + (size_t)MTOK * 4096 * 2);
static_assert(OFF_FFN_END <= (size_t)512 * 1024 * 1024, "ws overflow");

__device__ __forceinline__ bf16_t f2bf(float f) {
  unsigned u = __float_as_uint(f);
  u += 0x7fffu + ((u >> 16) & 1u);
  return (bf16_t)(u >> 16);
}
__device__ __forceinline__ unsigned cvtpk(float lo, float hi) {
  unsigned r;
  asm volatile("v_cvt_pk_bf16_f32 %0, %1, %2" : "=v"(r) : "v"(lo), "v"(hi));
  return r;
}
__device__ __forceinline__ int opaque_tid(const int wv) {
  int l;
  asm volatile("v_mbcnt_lo_u32_b32 %0, -1, 0\n\tv_mbcnt_hi_u32_b32 %0, -1, %0" : "=v"(l));
  return wv * 64 + l;
}
__device__ __forceinline__ float bf2f(bf16_t h) { return __uint_as_float(((unsigned)h) << 16); }
__device__ __forceinline__ float sigmoidf_(float v) { return 1.f / (1.f + __expf(-v)); }

__device__ __forceinline__ float block_sum(float v, float* red, int tid) {
  for (int o = 32; o > 0; o >>= 1) v += __shfl_xor(v, o);
  __syncthreads();
  if ((tid & 63) == 0) red[tid >> 6] = v;
  __syncthreads();
  float s = 0.f;
  for (int i = 0; i < (int)(blockDim.x >> 6); ++i) s += red[i];
  return s;
}

__device__ __forceinline__ float2 cossin_reduced(float ang) {
  const float k = rintf(ang * 0.15915494309189535f);
  float r = fmaf(-k, 6.28125f, ang);
  r = fmaf(-k, 1.9350051879882812e-3f, r);
  r = fmaf(-k, 3.0199159819809e-7f, r);
  return make_float2(__cosf(r), __sinf(r));
}

__device__ void phase_mod(const P& p, float* sm, const int wv) {
  float* mod = (float*)(p.ws + OFF_MOD);
  float2* tabA = (float2*)(p.ws + OFF_TABA);
  float2* tabR = (float2*)(p.ws + OFF_TABR);
  const int tid = opaque_tid(wv);
  int gt = blockIdx.x * blockDim.x + tid, gs = gridDim.x * blockDim.x;
  {
    float* sc = sm;
    float* red = sm + 8192;
    for (int slab = blockIdx.x; slab < 192; slab += gridDim.x) {
      __syncthreads();
      for (int i = tid; i < 8192; i += NTHR) { float cv = p.c[i]; sc[i] = cv / (1.f + __expf(-cv)); }
      __syncthreads();
      const int col = slab * 32 + (tid & 31), kp = tid >> 5;
      float acc[8];
#pragma unroll
      for (int bb = 0; bb < 8; ++bb) acc[bb] = 0.f;
      const float* wp = p.w_ada + (size_t)(kp * 64) * 6144 + col;
#pragma unroll 8
      for (int k = 0; k < 64; ++k) {
        const float w = wp[(size_t)k * 6144];
#pragma unroll
        for (int bb = 0; bb < 8; ++bb) acc[bb] += sc[bb * 1024 + kp * 64 + k] * w;
      }
#pragma unroll
      for (int bb = 0; bb < 8; ++bb) red[(kp * 8 + bb) * 32 + (tid & 31)] = acc[bb];
      __syncthreads();
      if (tid < 256) {
        const int bb = tid >> 5, cc = tid & 31;
        float s = p.b_ada[slab * 32 + cc];
#pragma unroll
        for (int q = 0; q < 16; ++q) s += red[(q * 8 + bb) * 32 + cc];
        mod[bb * 6144 + slab * 32 + cc] = s;
      }
    }
  }
  for (int o = gt; o < 4096 * 32; o += gs) {
    int s = o / 32, i = o % 32;
    float inv = powf(10000.f, -(float)(2 * i) / 64.f);
    float ang = (float)s * inv;
    tabA[o] = cossin_reduced(ang);
  }
  for (int o = gt; o < 4096 * 64; o += gs) {
    int s = o / 64, i = o % 64;
    float inv = 1.0f / powf(10000.f, (float)i / 63.f);
    float ang = (float)s * inv;
    tabR[o] = cossin_reduced(ang);
  }
}

__device__ void phase_norm(const float* src, const float* gain, const float* mod, int so, int sc, bf16_t* dst,
                           int tok0, int ntok, const int wv) {
  const int tid = opaque_tid(wv), lane = tid & 63, wid = tid >> 6;
  const int nwav = gridDim.x * 8, rpw = (ntok / nwav) & ~3;
  const int r0 = (blockIdx.x * 8 + wid) * rpw;
  const int b = (tok0 + r0) / S;
  const float* mb = mod + b * 6144 + lane * 4;
  const float* gp = gain + lane * 4;
  float4 mul[4], add[4];
#pragma unroll
  for (int i = 0; i < 4; ++i) {
    const float4 g = *(const float4*)(gp + i * 256);
    const float4 scl = *(const float4*)(mb + sc + i * 256);
    add[i] = *(const float4*)(mb + so + i * 256);
    mul[i] = make_float4(g.x * (1.f + scl.x), g.y * (1.f + scl.y), g.z * (1.f + scl.z), g.w * (1.f + scl.w));
  }
#pragma unroll 1
  for (int rb = 0; rb < rpw; rb += 4) {
    float4 v[4][4];
#pragma unroll
    for (int q = 0; q < 4; ++q) {
      const float* sp = src + (size_t)(tok0 + r0 + rb + q) * D + lane * 4;
#pragma unroll
      for (int i = 0; i < 4; ++i) v[q][i] = *(const float4*)(sp + i * 256);
    }
#pragma unroll
    for (int q = 0; q < 4; ++q) {
      float ss = 0.f;
#pragma unroll
      for (int i = 0; i < 4; ++i) ss += v[q][i].x * v[q][i].x + v[q][i].y * v[q][i].y + v[q][i].z * v[q][i].z + v[q][i].w * v[q][i].w;
#pragma unroll
      for (int o = 32; o > 0; o >>= 1) ss += __shfl_xor(ss, o);
      const float rstd = rsqrtf(ss * (1.f / D) + EPS);
      bf16_t* dp = dst + (size_t)(r0 + rb + q) * D + lane * 4;
#pragma unroll
      for (int i = 0; i < 4; ++i) {
        uint2 pk;
        pk.x = cvtpk(v[q][i].x * rstd * mul[i].x + add[i].x, v[q][i].y * rstd * mul[i].y + add[i].y);
        pk.y = cvtpk(v[q][i].z * rstd * mul[i].z + add[i].z, v[q][i].w * rstd * mul[i].w + add[i].w);
        *(uint2*)(dp + i * 256) = pk;
      }
    }
  }
  for (int r = nwav * rpw + blockIdx.x * 8 + wid; r < ntok; r += nwav) {
    const int T = tok0 + r, bb = T / S;
    const float* sp = src + (size_t)T * D + lane * 4;
    const float* mb2 = mod + bb * 6144 + lane * 4;
    float4 v[4];
#pragma unroll
    for (int i = 0; i < 4; ++i) v[i] = *(const float4*)(sp + i * 256);
    float ss = 0.f;
#pragma unroll
    for (int i = 0; i < 4; ++i) ss += v[i].x * v[i].x + v[i].y * v[i].y + v[i].z * v[i].z + v[i].w * v[i].w;
#pragma unroll
    for (int o = 32; o > 0; o >>= 1) ss += __shfl_xor(ss, o);
    const float rstd = rsqrtf(ss * (1.f / D) + EPS);
    bf16_t* dp = dst + (size_t)r * D + lane * 4;
#pragma unroll
    for (int i = 0; i < 4; ++i) {
      const float4 g = *(const float4*)(gp + i * 256);
      const float4 scl = *(const float4*)(mb2 + sc + i * 256);
      const float4 sh = *(const float4*)(mb2 + so + i * 256);
      uint2 pk;
      pk.x = cvtpk(v[i].x * rstd * g.x * (1.f + scl.x) + sh.x, v[i].y * rstd * g.y * (1.f + scl.y) + sh.y);
      pk.y = cvtpk(v[i].z * rstd * g.z * (1.f + scl.z) + sh.z, v[i].w * rstd * g.w * (1.f + scl.w) + sh.w);
      *(uint2*)(dp + i * 256) = pk;
    }
  }
}

#define LAS __attribute__((address_space(3)))
typedef short bf16x8 __attribute__((ext_vector_type(8)));
typedef float f32x4 __attribute__((ext_vector_type(4)));


__device__ __forceinline__ int perm32_slot(int f) { const int g = f & ~31, x = f & 31; return g + 16 * ((x >> 2) & 1) + 4 * (x >> 3) + (x & 3); }
__device__ __forceinline__ int win_row(int n) {
  const int tile = n >> 8, f = n & 255;
  if (n < 2048) { const int wc = f >> 6, q = f & 63; return (tile << 8) + 128 * (q >> 5) + 32 * wc + (q & 31); }
  if (n >= 3072 && n < 4096) { const int head = f >> 7, d = f & 127; return (tile << 8) + 128 * (d >> 6) + 32 * (head * 2 + ((d >> 5) & 1)) + (d & 31); }
  if (n >= 5120) return perm32_slot(n);
  return n;
}
__device__ void transpose_w(const float* W, int K, int N, bf16_t* dst, int ldd, int koff, float* sm, int wperm, const int wv) {
  const int tid = opaque_tid(wv);
  const int nkt = K / 64, nnt = N / 64, ntl = nkt * nnt;
  for (int t = blockIdx.x; t < ntl; t += 2 * gridDim.x) {
    __syncthreads();
#pragma unroll
    for (int u = 0; u < 2; ++u) {
      const int tu = t + u * gridDim.x;
      if (tu < ntl) {
        const int k0 = (tu / nnt) * 64, n0 = (tu % nnt) * 64;
#pragma unroll
        for (int r = 0; r < 8; ++r) {
          const int k = r * 8 + (tid >> 6), n = tid & 63;
          sm[u * 4160 + k * 65 + n] = W[(size_t)(k0 + k) * N + n0 + n];
        }
      }
    }
    __syncthreads();
#pragma unroll
    for (int u = 0; u < 2; ++u) {
      const int tu = t + u * gridDim.x;
      if (tu < ntl) {
        const int k0 = (tu / nnt) * 64, n0 = (tu % nnt) * 64;
        const int n = tid >> 3, ks = (tid & 7) * 8;
        const int nr = (wperm == 1) ? win_row(n0 + n) : (wperm == 2) ? perm32_slot(n0 + n) : (n0 + n);
        const float* s = sm + u * 4160 + n;
        uint4 pk;
        pk.x = cvtpk(s[(ks + 0) * 65], s[(ks + 1) * 65]); pk.y = cvtpk(s[(ks + 2) * 65], s[(ks + 3) * 65]);
        pk.z = cvtpk(s[(ks + 4) * 65], s[(ks + 5) * 65]); pk.w = cvtpk(s[(ks + 6) * 65], s[(ks + 7) * 65]);
        *(uint4*)(dst + (size_t)nr * ldd + koff + k0 + ks) = pk;
      }
    }
  }
}

__device__ __forceinline__ void tile_map(int t, int nM, int nN, int& pm, int& pn) {
  int w = t >> 8, l = t & 255, xcd = l & 7, idx = l >> 3;
  if ((nN & 15) == 0 && (nM & 15) == 0) {
    int sc = nN >> 4;
    int sr = w / sc, scc = w % sc;
    pm = sr * 16 + (xcd >> 1) * 4 + (idx >> 3);
    pn = scc * 16 + (xcd & 1) * 8 + (idx & 7);
  } else if (nN == 4 && (nM & 63) == 0) {
    pm = w * 64 + xcd * 8 + (idx >> 2);
    pn = idx & 3;
  } else {
    pm = t / nN; pn = t % nN;
  }
}


__device__ __forceinline__ int g8_lds_byte(int r, int c) {
  const int st = (r >> 4) * 2 + (c >> 5), rr = r & 15, cc = c & 31, ob = rr * 64 + cc * 2;
  return st * 1024 + (ob ^ (((ob >> 9) & 1) << 5));
}
__device__ __forceinline__ void g8_stage_rc(int b, int& R, int& C) {
  const int st = b / 1024, sb = b % 1024, swz = sb ^ (((sb >> 9) & 1) << 5);
  R = (st >> 1) * 16 + swz / 64; C = (st & 1) * 32 + (swz % 64) / 2;
}

template <class Epi>
__device__ __forceinline__ void gemm_phase(LAS char* lds, const char* Abase, const char* Bbase, const int K, const int nM, const int nN, const Epi& E, const int wv) {
  constexpr int HTB = 16384;
  const int tid = opaque_tid(wv), wid = __builtin_amdgcn_readfirstlane(tid >> 6), lane = tid & 63, wr = wid >> 2, wc = wid & 3, fr = lane & 15, fq = lane >> 4;
  const int nt = K / 64, ntiles = nM * nN;
  unsigned voff[2];
#pragma unroll
  for (int i = 0; i < 2; ++i) { int R, C; g8_stage_rc(tid * 16 + i * 8192, R, C); voff[i] = (unsigned)(R * K + C) * 2u; }
  const size_t kstep = 128, hstep = (size_t)128 * K * 2, tstep = 2 * hstep;
  const unsigned ldsw = (unsigned)wid * 1024u;
  const int aoff = g8_lds_byte(wr * 64 + fr, fq * 8), boff = g8_lds_byte(wc * 32 + fr, fq * 8);
#define G8_SA(b, h) (((b) * 2 + (h)) * HTB)
#define G8_SB(b, h) ((4 + (b) * 2 + (h)) * HTB)
#define G8_STAGE(bufoff, gbase) do { _Pragma("unroll") for (int _i = 0; _i < 2; ++_i) \
    __builtin_amdgcn_global_load_lds((const unsigned*)((const char*)(gbase) + voff[_i]), (LAS unsigned*)(lds + (bufoff) + ldsw + _i * 8192), 16, 0, 0); } while (0)
#define G8_LDA(dst, b, h) do { _Pragma("unroll") for (int m = 0; m < 4; ++m) _Pragma("unroll") for (int k = 0; k < 2; ++k) dst[m][k] = *(const LAS bf16x8*)(lds + G8_SA(b, h) + aoff + m * 2048 + k * 1024); } while (0)
#define G8_LDB(dst, b, h) do { _Pragma("unroll") for (int n = 0; n < 2; ++n) _Pragma("unroll") for (int k = 0; k < 2; ++k) dst[n][k] = *(const LAS bf16x8*)(lds + G8_SB(b, h) + boff + n * 2048 + k * 1024); } while (0)
#define G8_MMA(ai, bj, At, Bt) do { __builtin_amdgcn_s_setprio(1); _Pragma("unroll") for (int m = 0; m < 4; ++m) _Pragma("unroll") for (int n = 0; n < 2; ++n) _Pragma("unroll") for (int k = 0; k < 2; ++k) \
    acc[ai][bj][m][n] = __builtin_amdgcn_mfma_f32_16x16x32_bf16(Bt[n][k], At[m][k], acc[ai][bj][m][n], 0, 0, 0); __builtin_amdgcn_s_setprio(0); } while (0)
#define G8_WAIT_V(n) asm volatile("s_waitcnt vmcnt(" #n ")" ::: "memory")
#define G8_WAIT_L(n) asm volatile("s_waitcnt lgkmcnt(" #n ")" ::: "memory")
#define G8_BAR __builtin_amdgcn_s_barrier()
#define G8_SCHED __builtin_amdgcn_sched_barrier(0)
  int ui = 0;
  int t0 = blockIdx.x;
  if (t0 >= ntiles) return;
  int cpm, cpn; tile_map(t0, nM, nN, cpm, cpn);
  f32x4 acc[2][2][4][2];
#pragma unroll
  for (int a = 0; a < 2; ++a)
#pragma unroll
    for (int b = 0; b < 2; ++b)
#pragma unroll
      for (int m = 0; m < 4; ++m)
#pragma unroll
        for (int n = 0; n < 2; ++n) acc[a][b][m][n] = (f32x4){0.f, 0.f, 0.f, 0.f};
  bf16x8 At[4][2], B0[2][2], B1[2][2];
  const bool csw = E.swapped(cpn);
  const char* cA = csw ? Bbase + (size_t)cpn * tstep : Abase + (size_t)cpm * tstep;
  const char* cB = csw ? Abase + (size_t)cpm * tstep : Bbase + (size_t)cpn * tstep;
  G8_STAGE(G8_SB(0, 0), cB); G8_STAGE(G8_SA(0, 0), cA); G8_STAGE(G8_SB(0, 1), cB + hstep); G8_STAGE(G8_SA(0, 1), cA + hstep);
  if (wr == 1) G8_BAR;
  G8_WAIT_V(4); G8_BAR;
  G8_STAGE(G8_SB(1, 0), cB + kstep); G8_STAGE(G8_SA(1, 0), cA + kstep); G8_STAGE(G8_SB(1, 1), cB + hstep + kstep);
  G8_WAIT_V(6); G8_BAR;
  for (;;) {
    const int tn = blockIdx.x + (ui + 1) * gridDim.x;
    const bool has_next = tn < ntiles;
    int npm = cpm, npn = cpn;
    if (has_next) tile_map(tn, nM, nN, npm, npn);
    const bool nsw = has_next && E.swapped(npn);
    const char* nA = has_next ? (nsw ? Bbase + (size_t)npn * tstep : Abase + (size_t)npm * tstep) : cA;
    const char* nB = has_next ? (nsw ? Abase + (size_t)npm * tstep : Bbase + (size_t)npn * tstep) : cB;
    for (int t = 0; t < nt; t += 2) {
      const bool last = (t == nt - 2);
      const char* a1 = cA + (size_t)(t + 1) * kstep;
      const char* a2 = last ? nA : cA + (size_t)(t + 2) * kstep; const char* b2 = last ? nB : cB + (size_t)(t + 2) * kstep;
      const char* a3 = a2 + kstep; const char* b3 = b2 + kstep;
      G8_LDB(B0, 0, 0); G8_SCHED; G8_LDA(At, 0, 0); G8_STAGE(G8_SA(1, 1), a1 + hstep);
      G8_WAIT_L(8); G8_BAR; G8_WAIT_L(0); G8_MMA(0, 0, At, B0); G8_BAR; G8_SCHED;
      G8_LDB(B1, 0, 1); G8_STAGE(G8_SB(0, 0), b2);
      G8_BAR; G8_WAIT_L(0); G8_MMA(0, 1, At, B1); G8_BAR;
      G8_LDA(At, 0, 1); G8_STAGE(G8_SA(0, 0), a2);
      G8_BAR; G8_WAIT_L(0); G8_MMA(1, 0, At, B0); G8_BAR; G8_SCHED;
      G8_STAGE(G8_SB(0, 1), b2 + hstep);
      G8_WAIT_V(6); G8_BAR; G8_MMA(1, 1, At, B1); G8_BAR;
      G8_LDB(B0, 1, 0); G8_SCHED; G8_LDA(At, 1, 0); G8_STAGE(G8_SA(0, 1), a2 + hstep);
      G8_WAIT_L(8); G8_BAR; G8_WAIT_L(0); G8_MMA(0, 0, At, B0); G8_BAR; G8_SCHED;
      G8_LDB(B1, 1, 1); G8_STAGE(G8_SB(1, 0), b3);
      G8_BAR; G8_WAIT_L(0); G8_MMA(0, 1, At, B1); G8_BAR;
      G8_LDA(At, 1, 1); G8_STAGE(G8_SA(1, 0), a3);
      G8_BAR; G8_WAIT_L(0); G8_MMA(1, 0, At, B0); G8_BAR; G8_SCHED;
      G8_STAGE(G8_SB(1, 1), b3 + hstep);
      G8_WAIT_V(6); G8_BAR; G8_MMA(1, 1, At, B1); G8_BAR;
    }
    { int fr2 = fr, fq2 = fq; asm volatile("" : "+v"(fr2), "+v"(fq2));
      E(acc, cpm, cpn, wr, wc, fr2, fq2); }
    if (!has_next) break;
#pragma unroll
    for (int a = 0; a < 2; ++a)
#pragma unroll
      for (int b = 0; b < 2; ++b)
#pragma unroll
        for (int m = 0; m < 4; ++m)
#pragma unroll
          for (int n = 0; n < 2; ++n) acc[a][b][m][n] = (f32x4){0.f, 0.f, 0.f, 0.f};
    cpm = npm; cpn = npn; cA = nA; cB = nB; ++ui;
  }
  G8_WAIT_V(0);
  if (wr == 0) G8_BAR;
  G8_BAR;
#undef G8_SA
#undef G8_SB
#undef G8_STAGE
#undef G8_LDA
#undef G8_LDB
#undef G8_MMA
#undef G8_WAIT_V
#undef G8_WAIT_L
#undef G8_BAR
#undef G8_SCHED
}

typedef f32x4 acc_t[2][2][4][2];
typedef unsigned u32x2 __attribute__((ext_vector_type(2)));

struct EpiUp {
  char* hid;
  __device__ __forceinline__ bool swapped(int) const { return false; }
  __device__ __forceinline__ void operator()(const acc_t& acc, int pm, int pn, int wr, int wc, int fr, int fq) const {
    const unsigned lo = (unsigned)(fr * DFF + fq * 8) * 2u;
#pragma unroll
    for (int ai = 0; ai < 2; ++ai)
#pragma unroll
      for (int m = 0; m < 4; ++m) {
        const size_t ub = ((size_t)(pm * 256 + ai * 128 + wr * 64 + m * 16) * DFF + pn * 256 + wc * 32) * 2;
#pragma unroll
        for (int bj = 0; bj < 2; ++bj) {
          const f32x4 v0 = acc[ai][bj][m][0], v1 = acc[ai][bj][m][1];
          float r[8] = {fmaxf(v0[0], 0.f), fmaxf(v0[1], 0.f), fmaxf(v0[2], 0.f), fmaxf(v0[3], 0.f),
                        fmaxf(v1[0], 0.f), fmaxf(v1[1], 0.f), fmaxf(v1[2], 0.f), fmaxf(v1[3], 0.f)};
          uint4 pk;
          pk.x = cvtpk(r[0] * r[0], r[1] * r[1]); pk.y = cvtpk(r[2] * r[2], r[3] * r[3]);
          pk.z = cvtpk(r[4] * r[4], r[5] * r[5]); pk.w = cvtpk(r[6] * r[6], r[7] * r[7]);
          *(uint4*)(hid + ub + (bj * 128) * 2 + lo) = pk;
        }
      }
  }
};

struct EpiRes {
  const char* src; char* dst; const char* gate; int tok0;
  __device__ __forceinline__ bool swapped(int) const { return false; }
  __device__ __forceinline__ void operator()(const acc_t& acc, int pm, int pn, int wr, int wc, int fr, int fq) const {
    const unsigned lo = (unsigned)(fr * D + fq * 4) * 4u;
    const unsigned lg = (unsigned)(fq * 4) * 4u;
    const int b = (tok0 + pm * 256) / S;
    const size_t ug = ((size_t)b * 6144 + pn * 256 + wc * 32) * 4;
    float4 g[4];
#pragma unroll
    for (int q = 0; q < 4; ++q) g[q] = *(const float4*)(gate + ug + ((q >> 1) * 128 + (q & 1) * 16) * 4 + lg);
    const size_t ub0 = ((size_t)(tok0 + pm * 256 + wr * 64) * D + pn * 256 + wc * 32) * 4;
#pragma unroll
    for (int hb = 0; hb < 4; ++hb) {
      const int ai = hb >> 1, m0 = (hb & 1) * 2;
      float4 xb[2][4];
#pragma unroll
      for (int mm = 0; mm < 2; ++mm)
#pragma unroll
        for (int q = 0; q < 4; ++q)
          xb[mm][q] = *(const float4*)(src + ub0 + (size_t)(ai * 128 + (m0 + mm) * 16) * D * 4 + ((q >> 1) * 128 + (q & 1) * 16) * 4 + lo);
      __builtin_amdgcn_sched_barrier(0);
#pragma unroll
      for (int mm = 0; mm < 2; ++mm)
#pragma unroll
        for (int q = 0; q < 4; ++q) {
          const f32x4 v = acc[ai][q >> 1][m0 + mm][q & 1];
          float4 o = xb[mm][q];
          o.x += g[q].x * v[0]; o.y += g[q].y * v[1]; o.z += g[q].z * v[2]; o.w += g[q].w * v[3];
          *(float4*)(dst + ub0 + (size_t)(ai * 128 + (m0 + mm) * 16) * D * 4 + ((q >> 1) * 128 + (q & 1) * 16) * 4 + lo) = o;
        }
      __builtin_amdgcn_sched_barrier(0);
    }
  }
};

struct EpiIn {
  char* ws; const float* gq; const float* gk;
  __device__ __forceinline__ bool swapped(int pn) const { return (pn >= 8 && pn < 12) || (pn >= 16 && pn < 20); }
  __device__ __forceinline__ void operator()(const acc_t& acc, int pm, int pn, int wr, int wc, int fr, int fq) const {
    const int brow = pm * 256, b = brow / S, sb = brow % S;
    const int fqp = (fq == 1) ? 2 : (fq == 2) ? 1 : fq;
    const int frp = (((fr >> 2) == 1) ? 2 : ((fr >> 2) == 2) ? 1 : (fr >> 2)) * 4 + (fr & 3);
    if (pn < 8) {
      const bool isk = pn >= 4;
      const int hm = (((pn * 256) & 1023) >> 6) + wc;
      const char* gain = (const char*)(isk ? gk : gq);
      char* dst = ws + (isk ? OFF_KA : OFF_QA);
      const char* tab = ws + OFF_TABA;
      const unsigned lo_q = (unsigned)(fr * 64 + fq * 4) * 2u;
      const unsigned lo_t = (unsigned)(fr * 32 + fq * 4) * 8u;
      const unsigned lo_g = (unsigned)(fq * 4) * 4u;
      float4 gl4[2], gh4[2];
#pragma unroll
      for (int n = 0; n < 2; ++n) { gl4[n] = *(const float4*)(gain + n * 64 + lo_g); gh4[n] = *(const float4*)(gain + 128 + n * 64 + lo_g); }
      float4 tb[2][4];
      const int su0 = sb + wr * 64;
#pragma unroll
      for (int q = 0; q < 4; ++q) tb[0][q] = *(const float4*)(tab + ((size_t)su0 * 32 + (q >> 1) * 16) * 8 + (q & 1) * 16 + lo_t);
#pragma unroll
      for (int it = 0; it < 8; ++it) {
        const int ai = it >> 2, m = it & 3;
        if (it + 1 < 8) {
          const int sun = su0 + ((it + 1) >> 2) * 128 + ((it + 1) & 3) * 16;
#pragma unroll
          for (int q = 0; q < 4; ++q) tb[(it + 1) & 1][q] = *(const float4*)(tab + ((size_t)sun * 32 + (q >> 1) * 16) * 8 + (q & 1) * 16 + lo_t);
        }
        __builtin_amdgcn_sched_barrier(0);
        const int su = su0 + ai * 128 + m * 16;
        float ss = 0.f;
#pragma unroll
        for (int bj = 0; bj < 2; ++bj)
#pragma unroll
          for (int n = 0; n < 2; ++n)
#pragma unroll
            for (int j = 0; j < 4; ++j) ss += acc[ai][bj][m][n][j] * acc[ai][bj][m][n][j];
        ss += __shfl_xor(ss, 16);
        ss += __shfl_xor(ss, 32);
        float rstd = rsqrtf(ss * (1.f / 64.f) + EPS);
        if (!isk) rstd *= 0.125f * 1.4426950408889634f;
        const size_t ub = (((size_t)(b * 16 + hm) * S + su) * 64) * 2;
#pragma unroll
        for (int n = 0; n < 2; ++n) {
          const float4 c01 = tb[it & 1][n * 2], c23 = tb[it & 1][n * 2 + 1];
          const float cs[4] = {c01.x, c01.z, c23.x, c23.z}, sn[4] = {c01.y, c01.w, c23.y, c23.w};
          const float gl[4] = {gl4[n].x, gl4[n].y, gl4[n].z, gl4[n].w}, gh[4] = {gh4[n].x, gh4[n].y, gh4[n].z, gh4[n].w};
          float o1[4], o2[4];
#pragma unroll
          for (int j = 0; j < 4; ++j) {
            const float x1 = acc[ai][0][m][n][j] * rstd * gl[j], x2 = acc[ai][1][m][n][j] * rstd * gh[j];
            o1[j] = x1 * cs[j] - x2 * sn[j];
            o2[j] = x2 * cs[j] + x1 * sn[j];
          }
          uint2 k1, k2;
          k1.x = cvtpk(o1[0], o1[1]); k1.y = cvtpk(o1[2], o1[3]);
          k2.x = cvtpk(o2[0], o2[1]); k2.y = cvtpk(o2[2], o2[3]);
          *(uint2*)(dst + ub + n * 32 + lo_q) = k1;
          *(uint2*)(dst + ub + 64 + n * 32 + lo_q) = k2;
        }
        __builtin_amdgcn_sched_barrier(0);
      }
    } else if ((pn >= 8 && pn < 12) || (pn >= 16 && pn < 20)) {
      const bool isr = pn >= 16;
      const int cb = (isr ? pn * 256 - 4096 : pn * 256 - 2048) + wr * 64;
      char* dst = ws + (isr ? OFF_VRT : OFF_VAT);
      const unsigned lo = (unsigned)(fr * S + (isr ? fqp * 4 : fq * 8)) * 2u;
#pragma unroll
      for (int ai = 0; ai < 2; ++ai)
#pragma unroll
        for (int m = 0; m < 4; ++m) {
          const size_t ub = (((size_t)b * 1024 + cb + ai * 128 + m * 16) * S + sb + wc * 32) * 2;
#pragma unroll
          for (int bj = 0; bj < 2; ++bj) {
            if (isr) {
#pragma unroll
              for (int n = 0; n < 2; ++n) {
                const f32x4 v = acc[ai][bj][m][n];
                uint2 pk; pk.x = cvtpk(v[0], v[1]); pk.y = cvtpk(v[2], v[3]);
                *(uint2*)(dst + ub + (bj * 128 + n * 16) * 2 + lo) = pk;
              }
            } else {
              const f32x4 v0 = acc[ai][bj][m][0], v1 = acc[ai][bj][m][1];
              uint4 pk; pk.x = cvtpk(v0[0], v0[1]); pk.y = cvtpk(v0[2], v0[3]); pk.z = cvtpk(v1[0], v1[1]); pk.w = cvtpk(v1[2], v1[3]);
              *(uint4*)(dst + ub + (bj * 128) * 2 + lo) = pk;
            }
          }
          __builtin_amdgcn_sched_barrier(0);
        }
    } else if (pn < 16) {
      const bool isk = pn >= 14;
      const int h = ((((pn * 256) - 3072) & 511) >> 7) + (wc >> 1), w1 = wc & 1;
      const float scl = isk ? 0.08838834764831845f : 1.f;
      char* dst = ws + (isk ? OFF_KR : OFF_QR);
      char* dstT = ws + OFF_KRT;
      const char* tab = ws + OFF_TABR;
      const unsigned lo_q = (unsigned)(fr * 128 + fqp * 4) * 2u;
      const unsigned lo_t = (unsigned)(fr * 64 + fq * 4) * 8u;
      const unsigned lo_T = (unsigned)((fq * 4) * S + frp) * 2u;
      const float lg2 = __log2f(1.f - exp2f(-5.f - (float)h));
      float4 tb[2][4];
      const int su0 = sb + wr * 64;
#pragma unroll
      for (int q = 0; q < 4; ++q) tb[0][q] = *(const float4*)(tab + ((size_t)su0 * 64 + w1 * 32 + (q >> 1) * 16) * 8 + (q & 1) * 16 + lo_t);
#pragma unroll
      for (int it = 0; it < 8; ++it) {
        const int ai = it >> 2, m = it & 3;
        if (it + 1 < 8) {
          const int sun = su0 + ((it + 1) >> 2) * 128 + ((it + 1) & 3) * 16;
#pragma unroll
          for (int q = 0; q < 4; ++q) tb[(it + 1) & 1][q] = *(const float4*)(tab + ((size_t)sun * 64 + w1 * 32 + (q >> 1) * 16) * 8 + (q & 1) * 16 + lo_t);
        }
        __builtin_amdgcn_sched_barrier(0);
        const int su = su0 + ai * 128 + m * 16;
        const size_t ub = (((size_t)(b * 4 + h) * S + su) * 128 + w1 * 32) * 2;
        const size_t ubT = (((size_t)(b * 4 + h) * 128 + w1 * 32) * S + su) * 2;
        const float dec = exp2f((float)(63 - ((su & 63) + fr)) * lg2);
#pragma unroll
        for (int n = 0; n < 2; ++n) {
          const float4 c01 = tb[it & 1][n * 2], c23 = tb[it & 1][n * 2 + 1];
          const float cs[4] = {c01.x, c01.z, c23.x, c23.z}, sn[4] = {c01.y, c01.w, c23.y, c23.w};
          float o1[4], o2[4];
#pragma unroll
          for (int j = 0; j < 4; ++j) {
            const float x1 = acc[ai][0][m][n][j], x2 = acc[ai][1][m][n][j];
            o1[j] = (x1 * cs[j] - x2 * sn[j]) * scl;
            o2[j] = (x2 * cs[j] + x1 * sn[j]) * scl;
          }
          uint2 k1, k2;
          k1.x = cvtpk(o1[0], o1[1]); k1.y = cvtpk(o1[2], o1[3]);
          k2.x = cvtpk(o2[0], o2[1]); k2.y = cvtpk(o2[2], o2[3]);
          *(uint2*)(dst + ub + n * 32 + lo_q) = k1;
          *(uint2*)(dst + ub + 128 + n * 32 + lo_q) = k2;
          if (isk) {
#pragma unroll
            for (int j = 0; j < 4; ++j) {
              *(bf16_t*)(dstT + ubT + (size_t)(n * 16 + j) * (S * 2) + lo_T) = (bf16_t)(cvtpk(o1[j] * dec, 0.f) & 0xffffu);
              *(bf16_t*)(dstT + ubT + (size_t)(64 + n * 16 + j) * (S * 2) + lo_T) = (bf16_t)(cvtpk(o2[j] * dec, 0.f) & 0xffffu);
            }
          }
        }
        __builtin_amdgcn_sched_barrier(0);
      }
    } else {
      const bool ism = pn >= 24;
      const int cb = (ism ? pn * 256 - 6144 : pn * 256 - 5120) + wc * 32;
      char* dst = ws + (ism ? OFF_MGT : OFF_SG);
      const int ldd = ism ? 2048 : 1024;
      const unsigned lo = (unsigned)(fr * ldd + fq * 8) * 2u;
#pragma unroll
      for (int ai = 0; ai < 2; ++ai)
#pragma unroll
        for (int m = 0; m < 4; ++m) {
          const size_t ub = ((size_t)(brow + ai * 128 + wr * 64 + m * 16) * ldd + cb) * 2;
#pragma unroll
          for (int bj = 0; bj < 2; ++bj) {
            float o[8];
#pragma unroll
            for (int q = 0; q < 8; ++q) {
              const float v = acc[ai][bj][m][q >> 2][q & 3];
              const float sgm = 1.f / (1.f + __expf(-v));
              o[q] = ism ? sgm : v * sgm;
            }
            uint4 pk;
            pk.x = cvtpk(o[0], o[1]); pk.y = cvtpk(o[2], o[3]); pk.z = cvtpk(o[4], o[5]); pk.w = cvtpk(o[6], o[7]);
            *(uint4*)(dst + ub + (bj * 128) * 2 + lo) = pk;
          }
          __builtin_amdgcn_sched_barrier(0);
        }
    }
  }
};

typedef float f32x16 __attribute__((ext_vector_type(16)));
typedef int i32x4 __attribute__((ext_vector_type(4)));

__device__ __forceinline__ void attn_item(const P& p, LAS char* lds, int b, int h, int qt, float lam, float shift, const int wv) {
  const int tid = opaque_tid(wv), lane = tid & 63, wid = __builtin_amdgcn_readfirstlane(tid >> 6);
  const int r = lane & 31, hh = lane >> 5;
  const char* qa = (const char*)(p.ws + OFF_QA);
  const char* ka = (const char*)(p.ws + OFF_KA);
  const char* vaT = (const char*)(p.ws + OFF_VAT);
  const int q0 = qt * 256 + wid * 32;
  const int mychunk = qt * 4 + (wid >> 1);
  const int ntile = qt * 4 + 4;
  const int srow = tid >> 3, spc = tid & 7, sc = spc ^ ((srow >> 1) & 7);
  const unsigned klo = (unsigned)(srow * 64 + sc * 8) * 2u;
  const unsigned vlo = (unsigned)(srow * S + sc * 8) * 2u;
  const size_t kub0 = (((size_t)(b * 16 + h * 2) * S) * 64) * 2;
  const size_t vub0 = (((size_t)b * 1024 + h * 128) * S) * 2;
  LAS char* sdst = lds + wid * 1024;
  {
    const size_t qub = (((size_t)(b * 16 + h * 2) * S + qt * 256) * 64) * 2;
#pragma unroll
    for (int m_ = 0; m_ < 2; ++m_)
#pragma unroll
      for (int i_ = 0; i_ < 4; ++i_)
        __builtin_amdgcn_global_load_lds((const unsigned*)(qa + qub + (size_t)m_ * (S * 64 * 2) + (size_t)i_ * (64 * 64 * 2) + klo),
                                         (LAS unsigned*)(sdst + 65536 + m_ * 32768 + i_ * 8192), 16, 0, 0);
  }
#define ATT_STAGE(kt, bufoff) do { \
    _Pragma("unroll") for (int m_ = 0; m_ < 2; ++m_) \
      __builtin_amdgcn_global_load_lds((const unsigned*)(ka + kub0 + (size_t)m_ * (S * 64 * 2) + (size_t)(kt) * (64 * 64 * 2) + klo), \
                                       (LAS unsigned*)(sdst + (bufoff) + m_ * 8192), 16, 0, 0); \
    _Pragma("unroll") for (int i_ = 0; i_ < 2; ++i_) \
      __builtin_amdgcn_global_load_lds((const unsigned*)(vaT + vub0 + (size_t)i_ * (64 * S * 2) + (size_t)(kt) * (64 * 2) + vlo), \
                                       (LAS unsigned*)(sdst + (bufoff) + 16384 + i_ * 8192), 16, 0, 0); \
  } while (0)

  const int fr = lane & 15, fq = lane >> 4;
  f32x4 O[2][2][8];
#pragma unroll
  for (int m = 0; m < 2; ++m)
#pragma unroll
    for (int qb = 0; qb < 2; ++qb)
#pragma unroll
      for (int d = 0; d < 8; ++d) O[m][qb][d] = (f32x4){0.f, 0.f, 0.f, 0.f};
  float l[2][2] = {{0.f, 0.f}, {0.f, 0.f}};
  f32x4 cinit = (f32x4){-shift, -shift, -shift, -shift};
  asm volatile("" : "+v"(cinit));
  int ko[2];
#pragma unroll
  for (int ks = 0; ks < 2; ++ks) ko[ks] = fr * 128 + (((4 * ks + fq) ^ (fr >> 1)) * 16);

  ATT_STAGE(0, 0);
  for (int kt = 0; kt < ntile; ++kt) {
    asm volatile("s_waitcnt vmcnt(0)" ::: "memory");
    __syncthreads();
    if (kt + 1 < ntile) ATT_STAGE(kt + 1, ((kt + 1) & 1) * 32768);
    if (kt <= mychunk) {
      LAS char* cb = lds + (kt & 1) * 32768;
      LAS char* qbase = lds + 65536 + wid * 4096;
      bf16x8 pf[2][2][2], kf[8], qf[9], vf[16];
#define LD_K16(m_, q_) (*(const LAS bf16x8*)(cb + (m_) * 8192 + ((q_) & 3) * 2048 + ko[(q_) >> 2]))
#define LD_Q16(i_) (*(const LAS bf16x8*)(qbase + ((i_) >> 2) * 32768 + (((i_) >> 1) & 1) * 2048 + ko[(i_) & 1]))
#define LD_V16(q_) (*(const LAS bf16x8*)(cb + 16384 + ((q_) >> 1) * 2048 + ko[(q_) & 1]))
#pragma unroll
      for (int q = 0; q < 8; ++q) kf[q] = LD_K16(0, q);
      qf[0] = LD_Q16(0);
#pragma unroll
      for (int m = 0; m < 2; ++m) {
#pragma unroll
        for (int qb = 0; qb < 2; ++qb) {
          f32x4 s[4];
#pragma unroll
          for (int ks = 0; ks < 2; ++ks) {
            const int i = m * 4 + qb * 2 + ks;
            if (i + 1 < 8) qf[i + 1] = LD_Q16(i + 1);
            __builtin_amdgcn_sched_barrier(0);
            __builtin_amdgcn_s_setprio(1);
#pragma unroll
            for (int kb = 0; kb < 4; ++kb)
              s[kb] = __builtin_amdgcn_mfma_f32_16x16x32_bf16(kf[ks * 4 + kb], qf[i], ks == 0 ? cinit : s[kb], 0, 0, 0);
            __builtin_amdgcn_s_setprio(0);
            __builtin_amdgcn_sched_barrier(0);
          }
          if (qb == 1 && m == 0) {
#pragma unroll
            for (int q = 0; q < 8; ++q) kf[q] = LD_K16(1, q);
          }
          if (qb == 1 && m == 1) { vf[0] = LD_V16(0); vf[1] = LD_V16(1); vf[2] = LD_V16(2); }
          __builtin_amdgcn_sched_barrier(0);
          float ls = 0.f;
#pragma unroll
          for (int kb = 0; kb < 4; ++kb)
#pragma unroll
            for (int e = 0; e < 4; ++e) { s[kb][e] = __builtin_amdgcn_exp2f(s[kb][e]); ls += s[kb][e]; }
          l[m][qb] += ls;
#pragma unroll
          for (int t = 0; t < 2; ++t) {
            i32x4 pk;
            pk[0] = (int)cvtpk(s[2 * t][0], s[2 * t][1]); pk[1] = (int)cvtpk(s[2 * t][2], s[2 * t][3]);
            pk[2] = (int)cvtpk(s[2 * t + 1][0], s[2 * t + 1][1]); pk[3] = (int)cvtpk(s[2 * t + 1][2], s[2 * t + 1][3]);
            pf[m][qb][t] = __builtin_bit_cast(bf16x8, pk);
          }
          __builtin_amdgcn_sched_barrier(0);
        }
      }
#pragma unroll
      for (int q = 0; q < 16; ++q) {
        if (q + 3 < 16) vf[q + 3] = LD_V16(q + 3);
        __builtin_amdgcn_sched_barrier(0);
        __builtin_amdgcn_s_setprio(1);
#pragma unroll
        for (int m = 0; m < 2; ++m)
#pragma unroll
          for (int qb = 0; qb < 2; ++qb)
            O[m][qb][q >> 1] = __builtin_amdgcn_mfma_f32_16x16x32_bf16(vf[q], pf[m][qb][q & 1], O[m][qb][q >> 1], 0, 0, 0);
        __builtin_amdgcn_s_setprio(0);
        __builtin_amdgcn_sched_barrier(0);
      }
#undef LD_K16
#undef LD_Q16
#undef LD_V16
    }
  }
#undef ATT_STAGE
  {
    const char* mg = (const char*)(p.ws + OFF_MGT);
    char* u = (char*)(p.ws + OFF_U);
    const char* gda = (const char*)p.gda;
#pragma unroll
    for (int qb = 0; qb < 2; ++qb) {
      float l0 = l[0][qb], l1 = l[1][qb];
      l0 += __shfl_xor(l0, 16); l0 += __shfl_xor(l0, 32);
      l1 += __shfl_xor(l1, 16); l1 += __shfl_xor(l1, 32);
      const float i0 = 1.f / l0, i1 = lam / l1;
      float ss = 0.f;
#pragma unroll
      for (int d = 0; d < 8; ++d)
#pragma unroll
        for (int e = 0; e < 4; ++e) {
          const float v = O[0][qb][d][e] * i0 - O[1][qb][d][e] * i1;
          O[0][qb][d][e] = v;
          ss += v * v;
        }
      ss += __shfl_xor(ss, 16);
      ss += __shfl_xor(ss, 32);
      const float rstd = rsqrtf(ss * (1.f / 128.f) + EPS) * 0.8f;
      const size_t ub = (((size_t)b * S + q0 + qb * 16) * 2048 + h * 128) * 2;
      const unsigned lo = (unsigned)(fr * 2048 + fq * 4) * 2u;
      const size_t ubu = (((size_t)b * S + q0 + qb * 16) * 1024 + h * 128) * 2;
      const unsigned lou = (unsigned)(fr * 1024 + fq * 4) * 2u;
#pragma unroll
      for (int d = 0; d < 8; ++d) {
        const uint2 gm = *(const uint2*)(mg + ub + d * 32 + lo);
        const float4 gd = *(const float4*)(gda + d * 64 + fq * 16);
        const float g0 = __uint_as_float(gm.x << 16), g1 = __uint_as_float(gm.x & 0xffff0000u);
        const float g2 = __uint_as_float(gm.y << 16), g3 = __uint_as_float(gm.y & 0xffff0000u);
        uint2 pk;
        pk.x = cvtpk(O[0][qb][d][0] * rstd * gd.x * g0, O[0][qb][d][1] * rstd * gd.y * g1);
        pk.y = cvtpk(O[0][qb][d][2] * rstd * gd.z * g2, O[0][qb][d][3] * rstd * gd.w * g3);
        *(uint2*)(u + ubu + d * 32 + lou) = pk;
      }
    }
  }
}

__device__ __forceinline__ void ret_scan_item(const P& p, LAS char* lds, int b, int h, const int wv) {
  const int tid = opaque_tid(wv), lane = tid & 63, wid = __builtin_amdgcn_readfirstlane(tid >> 6);
  const int r = lane & 31, hh = lane >> 5;
  const float lg2 = __log2f(1.f - exp2f(-5.f - (float)h));
  const char* krT = (const char*)(p.ws + OFF_KRT);
  const char* vrT = (const char*)(p.ws + OFF_VRT);
  char* snap = (char*)(p.ws + OFF_SNAP);
  const int trow = tid >> 3, tc = (tid & 7) ^ ((trow >> 1) & 7);
  const unsigned ktlo = (unsigned)(trow * S + tc * 8) * 2u;
  const size_t ktub = (((size_t)(b * 4 + h) * 128) * S) * 2;
  LAS char* sdst = lds + wid * 1024;
#define SCAN_STAGE(c0, bufoff) do { \
    _Pragma("unroll") for (int i_ = 0; i_ < 2; ++i_) \
      __builtin_amdgcn_global_load_lds((const unsigned*)(krT + ktub + (size_t)i_ * (64 * S * 2) + (size_t)(c0) * 128 + ktlo), \
                                       (LAS unsigned*)(sdst + (bufoff) + i_ * 8192), 16, 0, 0); \
  } while (0)
  int ft4[4];
#pragma unroll
  for (int st = 0; st < 4; ++st) ft4[st] = r * 128 + (((2 * st + hh) ^ ((r >> 1) & 7)) * 16);
  const unsigned vlo = (unsigned)(r * S + hh * 8) * 2u;
  const size_t vub = (((size_t)(b * 4 + h) * 256 + wid * 32) * S) * 2;
  const size_t sub = ((size_t)(b * 4 + h) * 64) * 65536 + (size_t)wid * 8192;
  f32x16 st_[4];
#pragma unroll
  for (int d = 0; d < 4; ++d)
#pragma unroll
    for (int e = 0; e < 16; ++e) st_[d][e] = 0.f;
  const float g64 = exp2f(64.f * lg2);
  bf16x8 vf[4], vfn[4];
  SCAN_STAGE(0, 0);
#pragma unroll
  for (int st = 0; st < 4; ++st) vf[st] = *(const bf16x8*)(vrT + vub + st * 32 + vlo);
  for (int c = 0; c < 64; ++c) {
    asm volatile("s_waitcnt vmcnt(0)" ::: "memory");
    __syncthreads();
    if (c + 1 < 64) {
      SCAN_STAGE(c + 1, ((c + 1) & 1) * 16384);
#pragma unroll
      for (int st = 0; st < 4; ++st) vfn[st] = *(const bf16x8*)(vrT + vub + (size_t)(c + 1) * 128 + st * 32 + vlo);
    }
#pragma unroll
    for (int d = 0; d < 4; ++d)
#pragma unroll
      for (int s2 = 0; s2 < 2; ++s2) {
        i32x4 pk;
        pk[0] = (int)cvtpk(st_[d][8 * s2 + 0], st_[d][8 * s2 + 1]);
        pk[1] = (int)cvtpk(st_[d][8 * s2 + 2], st_[d][8 * s2 + 3]);
        pk[2] = (int)cvtpk(st_[d][8 * s2 + 4], st_[d][8 * s2 + 5]);
        pk[3] = (int)cvtpk(st_[d][8 * s2 + 6], st_[d][8 * s2 + 7]);
        *(i32x4*)(snap + sub + (size_t)c * 65536 + (d * 2 + s2) * 1024 + lane * 16) = pk;
      }
    LAS char* cb = lds + (c & 1) * 16384;
#pragma unroll
    for (int d = 0; d < 4; ++d) {
#pragma unroll
      for (int e = 0; e < 16; ++e) st_[d][e] *= g64;
#pragma unroll
      for (int st = 0; st < 4; ++st) {
        bf16x8 tf = *(const LAS bf16x8*)(cb + d * 4096 + ft4[st]);
        st_[d] = __builtin_amdgcn_mfma_f32_32x32x16_bf16(tf, vf[st], st_[d], 0, 0, 0);
      }
    }
#pragma unroll
    for (int st = 0; st < 4; ++st) vf[st] = vfn[st];
  }
#undef SCAN_STAGE
}

__device__ __forceinline__ void ret_out_item(const P& p, LAS char* lds, int b, int h, int c, const int wv) {
  const int tid = opaque_tid(wv), lane = tid & 63, wid = __builtin_amdgcn_readfirstlane(tid >> 6);
  const int r = lane & 31, hh = lane >> 5;
  const float lg2 = __log2f(1.f - exp2f(-5.f - (float)h));
  const char* qr = (const char*)(p.ws + OFF_QR);
  const char* kr = (const char*)(p.ws + OFF_KR);
  const char* vrT = (const char*)(p.ws + OFF_VRT);
  const char* sg = (const char*)(p.ws + OFF_SG);
  const char* mg = (const char*)(p.ws + OFF_MGT);
  const char* gret = (const char*)p.gret;
  const char* snap = (const char*)(p.ws + OFF_SNAP);
  char* u = (char*)(p.ws + OFF_U);
  const int qrow = tid >> 4, qc = (tid & 15) ^ (qrow & 15);
  const unsigned qklo = (unsigned)(qrow * 128 + qc * 8) * 2u;
  const size_t qkub = (((size_t)(b * 4 + h) * S + c * 64) * 128) * 2;
  LAS char* sdst = lds + wid * 1024;
#pragma unroll
  for (int i_ = 0; i_ < 2; ++i_) {
    __builtin_amdgcn_global_load_lds((const unsigned*)(qr + qkub + i_ * 8192 + qklo), (LAS unsigned*)(sdst + i_ * 8192), 16, 0, 0);
    __builtin_amdgcn_global_load_lds((const unsigned*)(kr + qkub + i_ * 8192 + qklo), (LAS unsigned*)(sdst + 16384 + i_ * 8192), 16, 0, 0);
  }
  int fq8[8];
#pragma unroll
  for (int st = 0; st < 8; ++st) fq8[st] = r * 256 + (((2 * st + hh) ^ (r & 15)) * 16);
  const unsigned vlo = (unsigned)(r * S + hh * 8) * 2u;
  const size_t vub = (((size_t)(b * 4 + h) * 256 + wid * 32) * S) * 2;
  bf16x8 vf[4];
#pragma unroll
  for (int st = 0; st < 4; ++st) vf[st] = *(const bf16x8*)(vrT + vub + (size_t)c * 128 + st * 32 + vlo);
  bf16x8 af[8];
  {
    const size_t sub = ((size_t)(b * 4 + h) * 64 + c) * 65536 + (size_t)wid * 8192;
#pragma unroll
    for (int q = 0; q < 8; ++q) af[q] = *(const bf16x8*)(snap + sub + q * 1024 + lane * 16);
  }
  LAS float* ssum = (LAS float*)(lds + 32768);
  const float gi0 = exp2f((float)(r + 1) * lg2), gi1 = exp2f((float)(r + 33) * lg2);
  asm volatile("s_waitcnt vmcnt(0)" ::: "memory");
  __syncthreads();
  LAS char* cb = lds;
  const int rr = r - 4 * hh;
  bf16x8 pf[3][2];
#pragma unroll
  for (int blk = 0; blk < 3; ++blk) {
    const int jb = (blk == 2) ? 1 : 0, ib = (blk == 0) ? 0 : 1;
    f32x16 sa;
#pragma unroll
    for (int e = 0; e < 16; ++e) sa[e] = 0.f;
#pragma unroll
    for (int st = 0; st < 8; ++st) {
      bf16x8 kf = *(const LAS bf16x8*)(cb + 16384 + jb * 8192 + fq8[st]);
      bf16x8 qf = *(const LAS bf16x8*)(cb + ib * 8192 + fq8[st]);
      sa = __builtin_amdgcn_mfma_f32_32x32x16_bf16(kf, qf, sa, 0, 0, 0);
    }
#pragma unroll
    for (int e = 0; e < 16; ++e) {
      const int dl = rr + (ib * 32 - jb * 32 - (e & 3) - 8 * (e >> 2));
      const float dcy = __builtin_amdgcn_exp2f((float)dl * lg2);
      sa[e] = (dl >= 0) ? sa[e] * dcy : 0.f;
    }
#pragma unroll
    for (int s2 = 0; s2 < 2; ++s2) {
      i32x4 pk;
      pk[0] = (int)cvtpk(sa[8 * s2 + 0], sa[8 * s2 + 1]);
      pk[1] = (int)cvtpk(sa[8 * s2 + 2], sa[8 * s2 + 3]);
      pk[2] = (int)cvtpk(sa[8 * s2 + 4], sa[8 * s2 + 5]);
      pk[3] = (int)cvtpk(sa[8 * s2 + 6], sa[8 * s2 + 7]);
      pf[blk][s2] = __builtin_bit_cast(bf16x8, pk);
    }
  }
  f32x16 Y[2];
#pragma unroll
  for (int ib = 0; ib < 2; ++ib)
#pragma unroll
    for (int e = 0; e < 16; ++e) Y[ib][e] = 0.f;
#pragma unroll
  for (int q = 0; q < 8; ++q)
#pragma unroll
    for (int ib = 0; ib < 2; ++ib) {
      bf16x8 qf = *(const LAS bf16x8*)(cb + ib * 8192 + fq8[q]);
      Y[ib] = __builtin_amdgcn_mfma_f32_32x32x16_bf16(af[q], qf, Y[ib], 0, 0, 0);
    }
#pragma unroll
  for (int e = 0; e < 16; ++e) { Y[0][e] *= gi0; Y[1][e] *= gi1; }
#pragma unroll
  for (int s2 = 0; s2 < 2; ++s2) {
    Y[0] = __builtin_amdgcn_mfma_f32_32x32x16_bf16(vf[s2], pf[0][s2], Y[0], 0, 0, 0);
    Y[1] = __builtin_amdgcn_mfma_f32_32x32x16_bf16(vf[s2], pf[1][s2], Y[1], 0, 0, 0);
    Y[1] = __builtin_amdgcn_mfma_f32_32x32x16_bf16(vf[2 + s2], pf[2][s2], Y[1], 0, 0, 0);
  }
  {
    float s0 = 0.f, s1 = 0.f;
#pragma unroll
    for (int e = 0; e < 16; ++e) { s0 += Y[0][e] * Y[0][e]; s1 += Y[1][e] * Y[1][e]; }
    s0 += __shfl_xor(s0, 32);
    s1 += __shfl_xor(s1, 32);
    LAS float* sp = ssum + wid * 64;
    if (hh == 0) { sp[r] = s0; sp[32 + r] = s1; }
    __syncthreads();
    float t0 = 0.f, t1 = 0.f;
#pragma unroll
    for (int w8 = 0; w8 < 8; ++w8) { t0 += ssum[w8 * 64 + r]; t1 += ssum[w8 * 64 + 32 + r]; }
    const float rs[2] = {rsqrtf(t0 * (1.f / 256.f) + EPS), rsqrtf(t1 * (1.f / 256.f) + EPS)};
#pragma unroll
    for (int ib = 0; ib < 2; ++ib) {
      const size_t tk = (size_t)b * S + c * 64 + ib * 32;
      const unsigned col0 = (unsigned)(h * 256 + wid * 32 + hh * 4);
#pragma unroll
      for (int g = 0; g < 4; ++g) {
        const unsigned col = col0 + g * 8;
        const uint2 sv = *(const uint2*)(sg + (tk * 1024 + col) * 2 + (unsigned)(r * 1024) * 2u);
        const uint2 gv = *(const uint2*)(mg + (tk * 2048 + 1024 + col) * 2 + (unsigned)(r * 2048) * 2u);
        const float4 gr = *(const float4*)(gret + (wid * 32 + g * 8 + hh * 4) * 4);
        const float a0 = __uint_as_float(sv.x << 16) * __uint_as_float(gv.x << 16);
        const float a1 = __uint_as_float(sv.x & 0xffff0000u) * __uint_as_float(gv.x & 0xffff0000u);
        const float a2 = __uint_as_float(sv.y << 16) * __uint_as_float(gv.y << 16);
        const float a3 = __uint_as_float(sv.y & 0xffff0000u) * __uint_as_float(gv.y & 0xffff0000u);
        char* up = u + (tk * 1024 + col) * 2 + (unsigned)(r * 1024) * 2u;
        const uint2 ua = *(const uint2*)up;
        uint2 pk;
        pk.x = cvtpk(__uint_as_float(ua.x << 16) + Y[ib][4 * g + 0] * rs[ib] * gr.x * a0, __uint_as_float(ua.x & 0xffff0000u) + Y[ib][4 * g + 1] * rs[ib] * gr.y * a1);
        pk.y = cvtpk(__uint_as_float(ua.y << 16) + Y[ib][4 * g + 2] * rs[ib] * gr.z * a2, __uint_as_float(ua.y & 0xffff0000u) + Y[ib][4 * g + 3] * rs[ib] * gr.w * a3);
        *(uint2*)up = pk;
      }
    }
  }
}

__device__ void ret_out_phase(const P& p, LAS char* lds, const int wv) {
  const int nitems = NB * 4 * 64;
  for (int it = blockIdx.x; it < nitems; it += gridDim.x) {
    __syncthreads();
    ret_out_item(p, lds, it >> 8, (it >> 6) & 3, it & 63, wv);
  }
}

__device__ void attn_fast(const P& p, LAS char* lds, int g, const int wv) {
  float lam;
  {
    float s1 = 0.f, s2 = 0.f;
    for (int i = 0; i < 64; ++i) { s1 += p.lq1[i] * p.lk1[i]; s2 += p.lq2[i] * p.lk2[i]; }
    lam = __expf(s1) - __expf(s2) + 0.2f;
  }
  unsigned* cnt = (unsigned*)(p.ws + OFF_CNT) + g;
  LAS volatile int* slot = (LAS volatile int*)(lds + 131072);
  float gqm = 0.f, gkm = 0.f;
  for (int i = 0; i < 64; ++i) { gqm = fmaxf(gqm, fabsf(p.gq[i])); gkm = fmaxf(gkm, fabsf(p.gk[i])); }
  const float shift = 8.f * 1.4426950408889634f * gqm * gkm;
  const int nret = NB * 4;
  const int nitems = nret + NB * 8 * 16;
  for (;;) {
    __syncthreads();
    if (opaque_tid(wv) == 0) *slot = (int)atomicAdd(cnt, 1u);
    __syncthreads();
    const int it = *slot;
    if (it >= nitems) break;
    if (it < nret) { ret_scan_item(p, lds, it >> 2, it & 3, wv); continue; }
    const int ia = it - nret;
    const int qt = 15 - ia / (NB * 8), bh = ia % (NB * 8);
    attn_item(p, lds, bh >> 3, bh & 7, qt, lam, shift, wv);
  }
}

__device__ __forceinline__ P load_params() {
#if defined(__HIP_DEVICE_COMPILE__)
  const __attribute__((address_space(4))) P* kp = (const __attribute__((address_space(4))) P*)__builtin_amdgcn_kernarg_segment_ptr();
  asm volatile("" : "+s"(kp));
  return *kp;
#else
  return P{};
#endif
}

#define XB_TMO      128
#define XB_XCNT(j)  (256  + 64 * (j))
#define XB_XSUB(j)  (1280 + 64 * (j))
#define XB_XGEN(j)  (2304 + 64 * (j))
#define XB_TOP      3328
#define XB_TOPGEN   3392
#define XB_SPIN_CAP (1u << 18)
__device__ __forceinline__ unsigned xb_ld(unsigned* p) { return __hip_atomic_load(p, __ATOMIC_RELAXED, __HIP_MEMORY_SCOPE_AGENT); }
__device__ __forceinline__ unsigned xb_add(unsigned* p, unsigned v) { return __hip_atomic_fetch_add(p, v, __ATOMIC_RELAXED, __HIP_MEMORY_SCOPE_AGENT); }
__device__ __forceinline__ unsigned xb_xcc_id() { return (unsigned)__builtin_amdgcn_s_getreg((3 << 11) | 20) & 0xFu; }
#define XB_SPIN(cond, bar) do { unsigned _sp = 0; while (cond) { __builtin_amdgcn_s_sleep(1); \
    if ((++_sp & 255u) == 0u) { if (xb_ld(&(bar)[XB_TMO])) break; if (_sp > XB_SPIN_CAP) { atomicAdd(&(bar)[XB_TMO], 1u); break; } } } } while (0)

__device__ __forceinline__ void xb_complete(unsigned* bar, unsigned x, unsigned& nloc, unsigned& nx) {
  const unsigned G = gridDim.x;
  unsigned sum, cnt, mine, sp = 0u;
  for (;;) {
    sum = 0u; cnt = 0u; mine = 0u;
#pragma unroll
    for (unsigned j = 0; j < 16; ++j) { const unsigned c = xb_ld(&bar[XB_XCNT(j)]); sum += c; cnt += (c > 0u) ? 1u : 0u; mine = (j == x) ? c : mine; }
    if (sum == G) break;
    __builtin_amdgcn_s_sleep(1);
    if ((++sp & 255u) == 0u) { if (xb_ld(&bar[XB_TMO])) break; if (sp > XB_SPIN_CAP) { atomicAdd(&bar[XB_TMO], 1u); break; } }
  }
  nloc = mine > 0u ? mine : 1u; nx = cnt > 0u ? cnt : 1u;
}

__device__ __forceinline__ void grid_bar(LAS char* lds, const int wv) {
  asm volatile("s_waitcnt vmcnt(0)" ::: "memory");
  __syncthreads();
  if (opaque_tid(wv) == 0) {
    unsigned* bar = (unsigned*)(load_params().ws + OFF_BAR);
    volatile LAS unsigned* st = (volatile LAS unsigned*)(lds + 131072 + 16);
    const unsigned x = xb_xcc_id();
    __builtin_amdgcn_s_waitcnt(0);
    unsigned nloc = st[0], nx = st[1];
    if (nloc == 0u) { xb_complete(bar, x, nloc, nx); st[0] = nloc; st[1] = nx; }
    const unsigned old = xb_add(&bar[XB_XSUB(x)], 1u);
    const unsigned gen = old / nloc;
    if (old + 1u == (gen + 1u) * nloc) {
      __builtin_amdgcn_fence(__ATOMIC_RELEASE, "agent");
      asm volatile("s_waitcnt vmcnt(0)" ::: "memory");
      const unsigned og = xb_add(&bar[XB_TOP], 1u);
      const unsigned tg = og / nx;
      if (og + 1u == (tg + 1u) * nx) xb_add(&bar[XB_TOPGEN], 1u);
      else XB_SPIN(xb_ld(&bar[XB_TOPGEN]) == tg, bar);
      __builtin_amdgcn_fence(__ATOMIC_ACQUIRE, "agent");
      xb_add(&bar[XB_XGEN(x)], 1u);
      asm volatile("s_waitcnt vmcnt(0)" ::: "memory");
    } else {
      XB_SPIN(xb_ld(&bar[XB_XGEN(x)]) == gen, bar);
      __builtin_amdgcn_fence(__ATOMIC_ACQUIRE, "agent");
      asm volatile("s_waitcnt vmcnt(0)" ::: "memory");
    }
  }
  __syncthreads();
}

__global__ void __launch_bounds__(NTHR) mega(P p_unused) {
  extern __shared__ __attribute__((aligned(16))) char smem_raw[];
  const int wv = __builtin_amdgcn_readfirstlane(threadIdx.x >> 6);
  cg::grid_group grid = cg::this_grid();
  LAS char* lds = (LAS char*)smem_raw;
  {
    const P p = load_params();
    float* sm = (float*)smem_raw;
    if (opaque_tid(wv) == 0) {
      volatile LAS unsigned* st = (volatile LAS unsigned*)(lds + 131072 + 16);
      st[0] = 0u; st[1] = 0u;
      (void)xb_add(&((unsigned*)(p.ws + OFF_BAR))[XB_XCNT(xb_xcc_id())], 1u);
    }
    phase_mod(p, sm, wv);
    transpose_w(p.w_in, 1024, INC, (bf16_t*)(p.ws + OFF_WIN), 1024, 0, sm, 1, wv);
    transpose_w(p.w_out, 1024, 1024, (bf16_t*)(p.ws + OFF_WOUT), 1024, 0, sm, 0, wv);
    transpose_w(p.w_up, 1024, DFF, (bf16_t*)(p.ws + OFF_WUP), 1024, 0, sm, 2, wv);
    transpose_w(p.w_down, DFF, 1024, (bf16_t*)(p.ws + OFF_WDN), DFF, 0, sm, 0, wv);
  }
  if (p_unused.ws == nullptr) grid.sync();
  grid_bar(lds, wv);
#pragma unroll 1
  for (int g = 0; g < NG; ++g) {
    {
      const P p = load_params();
      phase_norm(p.x, p.g1, (const float*)(p.ws + OFF_MOD), 0, 1024, (bf16_t*)(p.ws + OFF_HMIX), g * MG, MG, wv);
    }
    grid_bar(lds, wv);
    { const P p = load_params(); EpiIn e{p.ws, p.gq, p.gk}; gemm_phase(lds, p.ws + OFF_HMIX, p.ws + OFF_WIN, 1024, MG / 256, INC / 256, e, wv); }
    grid_bar(lds, wv);
    { const P p = load_params(); attn_fast(p, lds, g, wv); }
    grid_bar(lds, wv);
    { const P p = load_params(); ret_out_phase(p, lds, wv); }
    grid_bar(lds, wv);
    { const P p = load_params(); EpiRes e{(const char*)p.x, (char*)p.out, p.ws + OFF_MOD + 2048 * 4, g * MG}; gemm_phase(lds, p.ws + OFF_U, p.ws + OFF_WOUT, 1024, MG / 256, D / 256, e, wv); }
    if (g + 1 == NG) grid_bar(lds, wv);
  }
  {
    const P p = load_params();
    phase_norm(p.out, p.g2, (const float*)(p.ws + OFF_MOD), 3072, 4096, (bf16_t*)(p.ws + OFF_HFF), 0, MTOK, wv);
  }
  grid_bar(lds, wv);
  { const P p = load_params(); EpiUp e{p.ws + OFF_HID}; gemm_phase(lds, p.ws + OFF_HFF, p.ws + OFF_WUP, 1024, MTOK / 256, DFF / 256, e, wv); }
  grid_bar(lds, wv);
  { const P p = load_params(); EpiRes e{(const char*)p.out, (char*)p.out, p.ws + OFF_MOD + 5120 * 4, 0}; gemm_phase(lds, p.ws + OFF_HID, p.ws + OFF_WDN, DFF, MTOK / 256, D / 256, e, wv); }
}

extern "C" void kernel_launch(void* const* d_in, const int* in_sizes, int n_in, void* d_out, int out_size, void* d_ws,
                              size_t ws_size, hipStream_t stream) {
  static int grid_blocks = 0;
  if (!grid_blocks) {
    int dev = 0, cus = 0, per_cu = 0;
    hipGetDevice(&dev);
    hipDeviceGetAttribute(&cus, hipDeviceAttributeMultiprocessorCount, dev);
    hipFuncSetAttribute((const void*)mega, hipFuncAttributeMaxDynamicSharedMemorySize, (int)LDS_BYTES);
    hipOccupancyMaxActiveBlocksPerMultiprocessor(&per_cu, mega, NTHR, LDS_BYTES);
    if (per_cu < 1) per_cu = 1;
    if (per_cu > 1) per_cu = 1;
    grid_blocks = cus * per_cu;
  }
  P p{};
  p.x = (const float*)d_in[0]; p.c = (const float*)d_in[1]; p.w_ada = (const float*)d_in[2]; p.b_ada = (const float*)d_in[3];
  p.g1 = (const float*)d_in[4]; p.w_in = (const float*)d_in[5]; p.gq = (const float*)d_in[6]; p.gk = (const float*)d_in[7];
  p.lq1 = (const float*)d_in[8]; p.lk1 = (const float*)d_in[9]; p.lq2 = (const float*)d_in[10]; p.lk2 = (const float*)d_in[11];
  p.gda = (const float*)d_in[12]; p.gret = (const float*)d_in[13]; p.w_out = (const float*)d_in[14]; p.g2 = (const float*)d_in[15];
  p.w_up = (const float*)d_in[16]; p.w_down = (const float*)d_in[17];
  p.out = (float*)d_out; p.ws = (char*)d_ws;
  hipMemsetAsync((char*)d_ws + OFF_CNT, 0, (OFF_WIN - OFF_CNT), stream);
  void* args[] = {&p};
  hipError_t e = hipLaunchCooperativeKernel((const void*)mega, dim3(grid_blocks), dim3(NTHR), args, LDS_BYTES, stream);
  if (e != hipSuccess) fprintf(stderr, "cooperative launch failed: %s (grid %d)\n", hipGetErrorString(e), grid_blocks);
}
```
